# Optimizing an MI355X kernel written in HIP

```python
import jax, jax.numpy as jnp
from jax import lax
import numpy as np

D_MODEL = 1024
BATCH = 16
SEQ = 4096
DEPTH = 1

GLA_HEADS = 4
GLA_QK_WIDTH = D_MODEL // 2
GLA_V_WIDTH = D_MODEL
GLA_DK = GLA_QK_WIDTH // GLA_HEADS
GLA_DV = GLA_V_WIDTH // GLA_HEADS
GLA_GATE_RANK = 16
GLA_TAU = 16.0
GLA_CHUNK = 64
GLA_NORM_EPS = 1e-5
RWKV_HEAD_DIM = 64
RWKV_WIDTH = D_MODEL
RWKV_HEADS = RWKV_WIDTH // RWKV_HEAD_DIM
RWKV_DECAY_LORA = 64
RWKV_ICLR_LORA = 64
RWKV_GATE_LORA = 128
RWKV_GN_EPS = 64e-5
N_EXPERTS = 32
TOP_K = 4
EXPERT_FF = D_MODEL
SWIGLU_ALPHA = 1.702
SWIGLU_LIMIT = 7.0
MOE_BLOCK = 256
RMS_EPS = 1e-6

GLA_COLS = 2 * GLA_QK_WIDTH + GLA_V_WIDTH + GLA_GATE_RANK + GLA_V_WIDTH
RWKV_COLS = 3 * RWKV_WIDTH + RWKV_DECAY_LORA + RWKV_ICLR_LORA + RWKV_GATE_LORA
GATE_COLS = 2 * D_MODEL
IN_WIDTH = GLA_COLS + RWKV_COLS + GATE_COLS

kernel_name = 'hybrid_gla_rwkv7_moe_block'


def _split(z, sizes):
    out, start = [], 0
    for s in sizes:
        out.append(z[..., start:start + s])
        start += s
    return out


def rms_norm(x, gain, eps=RMS_EPS):
    xf = x.astype(jnp.float32)
    y = xf * lax.rsqrt(jnp.mean(xf * xf, axis=-1, keepdims=True) + eps)
    return y.astype(x.dtype) * gain


def gla_chunked(q, k, v, log_a):
    f32 = jnp.float32
    Bn, S, H, DK = q.shape
    DV = v.shape[-1]
    C = GLA_CHUNK
    N = S // C
    q = q.astype(f32).reshape(Bn, N, C, H, DK) * (DK ** -0.5)
    k = k.astype(f32).reshape(Bn, N, C, H, DK)
    v = v.astype(f32).reshape(Bn, N, C, H, DV)
    b = jnp.cumsum(log_a.astype(f32).reshape(Bn, N, C, H, DK), axis=2)
    b_ref = b[:, :, C // 2:C // 2 + 1]
    b_end = b[:, :, C - 1:]
    causal = jnp.tril(jnp.ones((C, C), dtype=bool))
    scores = jnp.einsum('bnihd,bnjhd->bnhij', q * jnp.exp(b - b_ref), k * jnp.exp(b_ref - b))
    scores = jnp.where(causal, scores, 0.0)
    o_intra = jnp.einsum('bnhij,bnjhv->bnihv', scores, v)
    q_in = q * jnp.exp(b)
    k_st = k * jnp.exp(b_end - b)
    decay = jnp.exp(b_end[:, :, 0])

    def step(state, inp):
        q_n, k_n, v_n, d_n = inp
        o_n = jnp.einsum('bihd,bhdv->bihv', q_n, state)
        state = state * d_n[..., None] + jnp.einsum('bjhd,bjhv->bhdv', k_n, v_n)
        return state, o_n

    state0 = jnp.zeros((Bn, H, DK, DV), f32)
    xs = (jnp.moveaxis(q_in, 1, 0), jnp.moveaxis(k_st, 1, 0), jnp.moveaxis(v, 1, 0), jnp.moveaxis(decay, 1, 0))
    _, o_inter = lax.scan(step, state0, xs)
    o = o_intra + jnp.moveaxis(o_inter, 0, 1)
    return o.reshape(Bn, S, H, DV)


def gla_branch(z_gla, gate_up, gate_bias, norm_g):
    Bn, S, _ = z_gla.shape
    q, k, v, gate_lr, o_gate = _split(z_gla, (GLA_QK_WIDTH, GLA_QK_WIDTH, GLA_V_WIDTH, GLA_GATE_RANK, GLA_V_WIDTH))
    log_a = jax.nn.log_sigmoid((gate_lr @ gate_up + gate_bias).astype(jnp.float32)) / GLA_TAU
    o = gla_chunked(q.reshape(Bn, S, GLA_HEADS, GLA_DK), k.reshape(Bn, S, GLA_HEADS, GLA_DK),
                    v.reshape(Bn, S, GLA_HEADS, GLA_DV), log_a.reshape(Bn, S, GLA_HEADS, GLA_DK))
    o = o * lax.rsqrt(jnp.mean(o * o, axis=-1, keepdims=True) + GLA_NORM_EPS) * norm_g
    o = o.reshape(Bn, S, GLA_V_WIDTH) * jax.nn.silu(o_gate.astype(jnp.float32))
    return o.astype(z_gla.dtype)


def rwkv7_scan(r, w, k, v, a_vec, b_vec):
    f32 = jnp.float32
    Bn, S, H, N = r.shape

    def step(state, inp):
        r_t, w_t, k_t, v_t, a_t, b_t = inp
        sa = jnp.einsum('bhij,bhj->bhi', state, a_t)
        state = state * w_t[:, :, None, :] + sa[..., None] * b_t[:, :, None, :] + v_t[..., None] * k_t[:, :, None, :]
        y_t = jnp.einsum('bhij,bhj->bhi', state, r_t)
        return state, y_t

    state0 = jnp.zeros((Bn, H, N, N), f32)
    xs = tuple(jnp.moveaxis(t.astype(f32), 1, 0) for t in (r, w, k, v, a_vec, b_vec))
    _, ys = lax.scan(step, state0, xs)
    return jnp.moveaxis(ys, 0, 1)


def rwkv7_branch(z_rwkv, mu, w0, w2, a0, a2, g2, k_k, k_a, r_k, ln_w, ln_b):
    f32 = jnp.float32
    Bn, S, _ = z_rwkv.shape
    prev = jnp.pad(z_rwkv, ((0, 0), (1, 0), (0, 0)))[:, :-1]
    u = z_rwkv + mu * (prev - z_rwkv)
    r, k, v, xw, xa, xg = _split(u, (RWKV_WIDTH, RWKV_WIDTH, RWKV_WIDTH, RWKV_DECAY_LORA, RWKV_ICLR_LORA, RWKV_GATE_LORA))
    w_log = -jax.nn.softplus(-(w0 + jnp.tanh(xw) @ w2).astype(f32)) - 0.5
    decay = jnp.exp(-jnp.exp(w_log))
    a = jax.nn.sigmoid((a0 + xa @ a2).astype(f32))
    g = jax.nn.sigmoid(xg) @ g2
    hs = (Bn, S, RWKV_HEADS, RWKV_HEAD_DIM)
    kf = k.astype(f32)
    kk = (kf * k_k).reshape(hs)
    kk = kk / jnp.maximum(jnp.sqrt(jnp.sum(kk * kk, axis=-1, keepdims=True)), 1e-12)
    kmod = (kf * (1.0 + (a - 1.0) * k_a)).reshape(hs)
    rf = r.astype(f32).reshape(hs)
    vf = v.astype(f32).reshape(hs)
    y = rwkv7_scan(rf, decay.reshape(hs), kmod, vf, -kk, kk * a.reshape(hs))
    mean = jnp.mean(y, axis=-1, keepdims=True)
    var = jnp.mean(jnp.square(y - mean), axis=-1, keepdims=True)
    y = ((y - mean) * lax.rsqrt(var + RWKV_GN_EPS)).reshape(Bn, S, RWKV_WIDTH) * ln_w + ln_b
    y = y + (jnp.sum(rf * kmod * r_k, axis=-1, keepdims=True) * vf).reshape(Bn, S, RWKV_WIDTH)
    return (y * g).astype(z_rwkv.dtype)


def hybrid_mixer(h, w_in, gla_gate_up, gla_gate_bias, gla_norm_g, rwkv_mu, rwkv_w0, rwkv_w2, rwkv_a0, rwkv_a2,
                 rwkv_g2, rwkv_k_k, rwkv_k_a, rwkv_r_k, rwkv_ln_w, rwkv_ln_b, w_branch_a, w_branch_b, w_out):
    z = h @ w_in
    z_gla, z_rwkv, z_gate = _split(z, (GLA_COLS, RWKV_COLS, GATE_COLS))
    y_a = gla_branch(z_gla, gla_gate_up, gla_gate_bias, gla_norm_g)
    y_b = rwkv7_branch(z_rwkv, rwkv_mu, rwkv_w0, rwkv_w2, rwkv_a0, rwkv_a2, rwkv_g2, rwkv_k_k, rwkv_k_a,
                       rwkv_r_k, rwkv_ln_w, rwkv_ln_b)
    gates = jax.nn.sigmoid(z_gate.astype(jnp.float32)).astype(h.dtype)
    g_a, g_b = _split(gates, (D_MODEL, D_MODEL))
    merged = g_a * (y_a @ w_branch_a) + g_b * (y_b @ w_branch_b)
    return merged @ w_out


def clamped_swiglu(hid):
    hid = hid.reshape(hid.shape[:-1] + (EXPERT_FF, 2))
    glu = jnp.minimum(hid[..., 0], SWIGLU_LIMIT)
    lin = jnp.clip(hid[..., 1], -SWIGLU_LIMIT, SWIGLU_LIMIT)
    return glu * jax.nn.sigmoid(SWIGLU_ALPHA * glu) * (lin + 1.0)


def moe_ffn(h, router_w, router_b, w1, b1, w2, b2):
    Bn, S, D = h.shape
    T = Bn * S
    t = h.reshape(T, D)
    logits = (t @ router_w + router_b).astype(jnp.float32)
    top_vals, top_idx = lax.top_k(logits, TOP_K)
    gates = jax.nn.softmax(top_vals, axis=-1)
    TK = T * TOP_K
    e_flat = top_idx.reshape(TK)
    tok_flat = jnp.arange(TK, dtype=jnp.int32) // TOP_K
    gate_flat = gates.reshape(TK).astype(t.dtype)
    order = jnp.argsort(e_flat, stable=True)
    e_sorted = e_flat[order]
    tok_sorted = tok_flat[order]
    gate_sorted = gate_flat[order]
    counts = jnp.bincount(e_flat, length=N_EXPERTS)
    starts = jnp.cumsum(counts) - counts
    padded = (counts + MOE_BLOCK - 1) // MOE_BLOCK * MOE_BLOCK
    pad_ends = jnp.cumsum(padded)
    pad_starts = pad_ends - padded
    dest = pad_starts[e_sorted] + (jnp.arange(TK) - starts[e_sorted])
    NB = -(-TK // MOE_BLOCK) + N_EXPERTS
    rows_tok = jnp.zeros((NB * MOE_BLOCK,), jnp.int32).at[dest].set(tok_sorted)
    rows_gate = jnp.zeros((NB * MOE_BLOCK,), t.dtype).at[dest].set(gate_sorted)
    block_expert = jnp.minimum(jnp.searchsorted(pad_ends, jnp.arange(NB) * MOE_BLOCK, side='right'), N_EXPERTS - 1)

    def block_fn(args):
        tok_b, gate_b, e = args
        hid = t[tok_b] @ w1[e] + b1[e]
        out = clamped_swiglu(hid) @ w2[e] + b2[e]
        return out * gate_b[:, None]

    outs = lax.map(block_fn, (rows_tok.reshape(NB, MOE_BLOCK), rows_gate.reshape(NB, MOE_BLOCK), block_expert))
    y = jax.ops.segment_sum(outs.reshape(NB * MOE_BLOCK, D), rows_tok, num_segments=T)
    return y.reshape(Bn, S, D).astype(h.dtype)


def setup_inputs(seed: int = 0) -> dict:
    key = jax.random.key(seed)
    ks = jax.random.split(key, 32)
    f32 = jnp.float32
    L = DEPTH

    def nrm(k, shape, scale):
        return jax.random.normal(k, shape, f32) * scale

    ramp = (jnp.arange(RWKV_WIDTH, dtype=f32) / (RWKV_WIDTH - 1)) ** 0.85
    return {
        'x': nrm(ks[0], (BATCH, SEQ, D_MODEL), 1.0),
        'norm_mix_g': 1.0 + nrm(ks[1], (L, D_MODEL), 0.02),
        'w_in': nrm(ks[2], (L, D_MODEL, IN_WIDTH), D_MODEL ** -0.5),
        'gla_gate_up': nrm(ks[3], (L, GLA_GATE_RANK, GLA_QK_WIDTH), GLA_GATE_RANK ** -0.5),
        'gla_gate_bias': nrm(ks[4], (L, GLA_QK_WIDTH), 0.5),
        'gla_norm_g': 1.0 + nrm(ks[5], (L, GLA_DV), 0.02),
        'rwkv_mu': jax.random.uniform(ks[6], (L, RWKV_COLS), f32),
        'rwkv_w0': -6.5 + 5.0 * ramp + nrm(ks[7], (L, RWKV_WIDTH), 0.1),
        'rwkv_w2': nrm(ks[8], (L, RWKV_DECAY_LORA, RWKV_WIDTH), 0.1 * RWKV_DECAY_LORA ** -0.5),
        'rwkv_a0': nrm(ks[9], (L, RWKV_WIDTH), 0.1),
        'rwkv_a2': nrm(ks[10], (L, RWKV_ICLR_LORA, RWKV_WIDTH), RWKV_ICLR_LORA ** -0.5),
        'rwkv_g2': nrm(ks[11], (L, RWKV_GATE_LORA, RWKV_WIDTH), RWKV_GATE_LORA ** -0.5),
        'rwkv_k_k': 0.85 + nrm(ks[12], (L, RWKV_WIDTH), 0.02),
        'rwkv_k_a': 1.0 + nrm(ks[13], (L, RWKV_WIDTH), 0.02),
        'rwkv_r_k': -0.04 + nrm(ks[14], (L, RWKV_HEADS, RWKV_HEAD_DIM), 0.02),
        'rwkv_ln_w': 1.0 + nrm(ks[15], (L, RWKV_WIDTH), 0.02),
        'rwkv_ln_b': nrm(ks[16], (L, RWKV_WIDTH), 0.02),
        'w_branch_a': nrm(ks[17], (L, GLA_V_WIDTH, D_MODEL), GLA_V_WIDTH ** -0.5),
        'w_branch_b': nrm(ks[18], (L, RWKV_WIDTH, D_MODEL), RWKV_WIDTH ** -0.5),
        'w_out': nrm(ks[19], (L, D_MODEL, D_MODEL), D_MODEL ** -0.5),
        'norm_ffn_g': 1.0 + nrm(ks[20], (L, D_MODEL), 0.02),
        'router_w': nrm(ks[21], (L, D_MODEL, N_EXPERTS), D_MODEL ** -0.5),
        'router_b': nrm(ks[22], (L, N_EXPERTS), 0.01),
        'expert_w1': nrm(ks[23], (L, N_EXPERTS, D_MODEL, 2 * EXPERT_FF), D_MODEL ** -0.5),
        'expert_b1': nrm(ks[24], (L, N_EXPERTS, 2 * EXPERT_FF), 0.01),
        'expert_w2': nrm(ks[25], (L, N_EXPERTS, EXPERT_FF, D_MODEL), EXPERT_FF ** -0.5),
        'expert_b2': nrm(ks[26], (L, N_EXPERTS, D_MODEL), 0.01),
        'norm_final_g': 1.0 + nrm(ks[27], (D_MODEL,), 0.02),
    }


def reference(x, norm_mix_g, w_in, gla_gate_up, gla_gate_bias, gla_norm_g, rwkv_mu, rwkv_w0, rwkv_w2, rwkv_a0,
              rwkv_a2, rwkv_g2, rwkv_k_k, rwkv_k_a, rwkv_r_k, rwkv_ln_w, rwkv_ln_b, w_branch_a, w_branch_b, w_out,
              norm_ffn_g, router_w, router_b, expert_w1, expert_b1, expert_w2, expert_b2, norm_final_g):
    for l in range(DEPTH):
        h = rms_norm(x, norm_mix_g[l])
        x = x + hybrid_mixer(h, w_in[l], gla_gate_up[l], gla_gate_bias[l], gla_norm_g[l], rwkv_mu[l], rwkv_w0[l],
                             rwkv_w2[l], rwkv_a0[l], rwkv_a2[l], rwkv_g2[l], rwkv_k_k[l], rwkv_k_a[l], rwkv_r_k[l],
                             rwkv_ln_w[l], rwkv_ln_b[l], w_branch_a[l], w_branch_b[l], w_out[l])
        h = rms_norm(x, norm_ffn_g[l])
        x = x + moe_ffn(h, router_w[l], router_b[l], expert_w1[l], expert_b1[l], expert_w2[l], expert_b2[l])
    return rms_norm(x, norm_final_g)
```

```cpp
#include <hip/hip_runtime.h>
#include <cstdio>
#include <cstdint>

#ifndef PROBE_MASK
#define PROBE_MASK 0
#endif
#define RUNPH(bit, ...) do { __VA_ARGS__ if constexpr (((PROBE_MASK >> (bit)) & 1) != 0) { __VA_ARGS__ } } while (0)
#ifndef RW_REP_AB
#define RW_REP_AB 1
#endif
#ifndef RW_REP_EW
#define RW_REP_EW 1
#endif
#ifndef GLA_FAST
#define GLA_FAST 1
#endif
#ifndef RWKV_FAST
#define RWKV_FAST 1
#endif
#ifndef N_LAUNCH_MODE
#define N_LAUNCH_MODE 0
#endif

#define LAS __attribute__((address_space(3)))
typedef unsigned short bf16_t;
typedef short bf16x8 __attribute__((ext_vector_type(8)));
typedef float f32x4 __attribute__((ext_vector_type(4)));
typedef float f32x2 __attribute__((ext_vector_type(2)));
typedef unsigned u32x4 __attribute__((ext_vector_type(4)));
typedef unsigned u32x2 __attribute__((ext_vector_type(2)));

constexpr int DM = 1024, SEQ = 4096, TH = 32768  , NBH = 8  ;
constexpr int ZLD = 8704;
constexpr int ZQ = 0, ZK = 512, ZV = 1024, ZOG = 2048, ZR = 3072, ZK2 = 4096, ZV2 = 5120, ZGA = 6144, ZGB = 7168, ZXW = 8192, ZXA = 8256, ZXG = 8320, ZGL = 8448;
constexpr int NEXP = 32, NROWS = 139264  , NBLK_MAX = 544;
constexpr int LDS_BYTES = 160 * 1024;
constexpr int MISC_OFF = LDS_BYTES - 256;

constexpr size_t WS_CTL = 0, CTL_BYTES = 65536;
constexpr size_t WS_WIN = WS_CTL + CTL_BYTES;
constexpr size_t WS_WA = WS_WIN + (size_t)ZLD * 1024 * 2;
constexpr size_t WS_WB = WS_WA + 2097152, WS_WO = WS_WB + 2097152;
constexpr size_t WS_W1 = WS_WO + 2097152;
constexpr size_t WS_W2 = WS_W1 + (size_t)32 * 2048 * 1024 * 2;
constexpr size_t WS_H = WS_W2 + (size_t)32 * 1024 * 1024 * 2;
constexpr size_t WS_Z = WS_H + (size_t)TH * 1024 * 2;
constexpr size_t WS_YB = WS_Z + (size_t)TH * ZLD * 2;
constexpr size_t WS_MG = WS_YB + (size_t)TH * 1024 * 2;
constexpr size_t WS_H2 = WS_MG + (size_t)TH * 1024 * 2;
constexpr size_t WS_RTOK = WS_H2 + (size_t)TH * 1024 * 2;
constexpr size_t WS_RGATE = WS_RTOK + (size_t)NROWS * 4;
constexpr size_t WS_DEST = WS_RGATE + (size_t)NROWS * 4;
constexpr size_t WS_TOPE = WS_DEST + (size_t)TH * 16;
constexpr size_t WS_TOPG = WS_TOPE + (size_t)TH * 16;
constexpr size_t WS_BLKE = WS_TOPG + (size_t)TH * 16;
constexpr size_t WS_END = WS_BLKE + 4096;
constexpr size_t WS_ACT = WS_Z, WS_OUTS = WS_Z + (size_t)NROWS * 1024 * 2;
static_assert(WS_OUTS + (size_t)NROWS * 1024 * 2 <= WS_YB, "ACT/OUTS overlay");
constexpr int CW_CNT = 4096, CW_CUR = 4352, CW_NBLK = 4608;

__device__ __forceinline__ float bf2f(unsigned short b) { return __uint_as_float(((unsigned)b) << 16); }
__device__ __forceinline__ float bflo(unsigned w) { return __uint_as_float(w << 16); }
__device__ __forceinline__ float bfhi(unsigned w) { return __uint_as_float(w & 0xffff0000u); }
typedef __bf16 bf16x2v __attribute__((ext_vector_type(2)));
__device__ __forceinline__ unsigned pk2(float lo, float hi) { f32x2 v = {lo, hi}; return __builtin_bit_cast(unsigned, __builtin_convertvector(v, bf16x2v)); }
__device__ __forceinline__ unsigned short f2bf(float f) { return (unsigned short)(pk2(f, 0.f) & 0xffffu); }
template <int CTRL> __device__ __forceinline__ float dpp_f(float x) { return __int_as_float(__builtin_amdgcn_update_dpp(0, __float_as_int(x), CTRL, 0xF, 0xF, true)); }
__device__ __forceinline__ float rowsum16(float x) {
    x += dpp_f<0xB1>(x); x += dpp_f<0x4E>(x); x += dpp_f<0x141>(x); x += dpp_f<0x140>(x); return x;
}
__device__ __forceinline__ float wave_sum(float v) {
    v = rowsum16(v);
    const int iv = __float_as_int(v);
    return (__int_as_float(__builtin_amdgcn_readlane(iv, 0)) + __int_as_float(__builtin_amdgcn_readlane(iv, 16))) + (__int_as_float(__builtin_amdgcn_readlane(iv, 32)) + __int_as_float(__builtin_amdgcn_readlane(iv, 48)));
}
__device__ __forceinline__ float frcp(float x) { return __builtin_amdgcn_rcpf(x); }
__device__ __forceinline__ float wave_max(float v) {
#pragma unroll
    for (int o = 32; o > 0; o >>= 1) v = fmaxf(v, __shfl_xor(v, o));
    return v;
}
__device__ __forceinline__ int wave_min_i(int v) {
#pragma unroll
    for (int o = 32; o > 0; o >>= 1) { int w = __shfl_xor(v, o); v = w < v ? w : v; }
    return v;
}
__device__ __forceinline__ float sigmoidf_(float x) { return frcp(1.0f + __expf(-x)); }
__device__ __forceinline__ float tanhf_(float x) { return 1.0f - 2.0f * frcp(1.0f + __expf(2.0f * x)); }
__device__ __forceinline__ float softplusf_(float y) { return fmaxf(y, 0.f) + 0.6931471805599453f * __builtin_amdgcn_logf(1.0f + __expf(-fabsf(y))); }

#define XB_TMO      128
#define XB_XCNT(j)  (256  + 64 * (j))
#define XB_XSUB(j)  (1280 + 64 * (j))
#define XB_XGEN(j)  (2304 + 64 * (j))
#define XB_TOP      3328
#define XB_TOPGEN   3392
#define XCD_BAR_WORDS 3456
#define XB_SPIN_CAP (1u << 22)
__device__ __forceinline__ unsigned xb_ld(unsigned* p)              { return __hip_atomic_load(p, __ATOMIC_RELAXED, __HIP_MEMORY_SCOPE_AGENT); }
__device__ __forceinline__ unsigned xb_add(unsigned* p, unsigned v) { return __hip_atomic_fetch_add(p, v, __ATOMIC_RELAXED, __HIP_MEMORY_SCOPE_AGENT); }
__device__ __forceinline__ unsigned xb_xcc_id() { return (unsigned)__builtin_amdgcn_s_getreg((3 << 11) | 20) & 0xFu; }
#define XB_SPIN(cond, bar) do { unsigned _sp = 0; while (cond) { __builtin_amdgcn_s_sleep(1); \
    if ((++_sp & 255u) == 0u) { if (xb_ld(&(bar)[XB_TMO])) break; if (_sp > XB_SPIN_CAP) { atomicAdd(&(bar)[XB_TMO], 1u); break; } } } } while (0)
struct XcdBarrier { unsigned* bar; unsigned x; volatile LAS unsigned* st; };
__device__ __forceinline__ XcdBarrier xcd_barrier_post(unsigned* bar, volatile LAS unsigned* st) {
    XcdBarrier b; b.bar = bar; b.x = xb_xcc_id(); b.st = st;
    if (threadIdx.x == 0) (void)xb_add(&bar[XB_XCNT(b.x)], 1u);
    return b;
}
__device__ __forceinline__ void xcd_barrier_complete(unsigned* bar, unsigned x, unsigned& nloc, unsigned& nx) {
    const unsigned G = gridDim.x * gridDim.y * gridDim.z;
    unsigned sum, cnt, mine, sp = 0u;
    for (;;) {
        sum = 0u; cnt = 0u; mine = 0u;
#pragma unroll
        for (unsigned j = 0; j < 16; ++j) { const unsigned c = xb_ld(&bar[XB_XCNT(j)]); sum += c; cnt += (c > 0u) ? 1u : 0u; mine = (j == x) ? c : mine; }
        if (sum == G) break;
        __builtin_amdgcn_s_sleep(1);
        if ((++sp & 255u) == 0u) { if (xb_ld(&bar[XB_TMO])) break; if (sp > XB_SPIN_CAP) { atomicAdd(&bar[XB_TMO], 1u); break; } }
    }
    nloc = mine > 0u ? mine : 1u; nx = cnt > 0u ? cnt : 1u;
}
__device__ __forceinline__ void xcd_barrier(const XcdBarrier& b) {
    asm volatile("s_waitcnt vmcnt(0)" ::: "memory");
    __syncthreads();
    if (threadIdx.x == 0) {
        unsigned* bar = b.bar;
        __builtin_amdgcn_s_waitcnt(0);
        unsigned nloc = b.st[0], nx = b.st[1];
        if (nloc == 0u) { xcd_barrier_complete(bar, b.x, nloc, nx); b.st[0] = nloc; b.st[1] = nx; }
        const unsigned old = xb_add(&bar[XB_XSUB(b.x)], 1u);
        const unsigned gen = old / nloc;
        if (old + 1u == (gen + 1u) * nloc) {
            __builtin_amdgcn_fence(__ATOMIC_RELEASE, "agent");
            asm volatile("s_waitcnt vmcnt(0)" ::: "memory");
            const unsigned og = xb_add(&bar[XB_TOP], 1u);
            const unsigned tg = og / nx;
            if (og + 1u == (tg + 1u) * nx) xb_add(&bar[XB_TOPGEN], 1u);
            else XB_SPIN(xb_ld(&bar[XB_TOPGEN]) == tg, bar);
            __builtin_amdgcn_fence(__ATOMIC_ACQUIRE, "agent");
            xb_add(&bar[XB_XGEN(b.x)], 1u);
            asm volatile("s_waitcnt vmcnt(0)" ::: "memory");
        } else {
            XB_SPIN(xb_ld(&bar[XB_XGEN(b.x)]) == gen, bar);
            __builtin_amdgcn_fence(__ATOMIC_ACQUIRE, "agent");
            asm volatile("s_waitcnt vmcnt(0)" ::: "memory");
        }
    }
    __syncthreads();
}

namespace pg8 {
constexpr int BM = 256, BK = 64, HALF = 128, HTB = HALF * BK * 2, STAGE_BYTES = 8 * HTB, NXCD = 8, WGM = 8;
__host__ __device__ __forceinline__ int lds_byte(int r, int c) { const int st = (r >> 4) * 2 + (c >> 5), rr = r & 15, cc = c & 31, ob = rr * 64 + cc * 2; return st * 1024 + (ob ^ (((ob >> 9) & 1) << 5)); }
__host__ __device__ __forceinline__ void stage_rc(int b, int& R, int& C) { const int st = b / 1024, sb = b % 1024, swz = sb ^ (((sb >> 9) & 1) << 5); R = (st >> 1) * 16 + swz / 64; C = (st & 1) * 32 + (swz % 64) / 2; }
__host__ __device__ __forceinline__ int perm32(int rho) { const int n = rho >> 4, i = rho & 15; return 8 * (i >> 2) + 4 * n + (i & 3); }
struct Unit { int pm, pn; };
struct Gemm { const bf16_t* A; const bf16_t* Bt; int K; };

struct StaticOrder {
    static constexpr bool GATHER = false;
    int nM, nN, nwg, G, c;
    __device__ void init(int M, int N, int G_, int c_) { nM = M / BM; nN = N / BM; nwg = nM * nN; G = G_; c = c_; }
    __device__ bool next(int i, Unit& u) const {
        const long L = (long)i * G + c; if (L >= nwg) return false;
        int wgid = (int)L; { const int q = nwg / NXCD, r = nwg % NXCD, xcd = wgid % NXCD, off = wgid / NXCD; wgid = (xcd < r ? xcd * (q + 1) : r * (q + 1) + (xcd - r) * q) + off; }
        const int nig = WGM * nN, gid = wgid / nig, fm = gid * WGM, gsz = (nM - fm) < WGM ? (nM - fm) : WGM;
        u.pm = fm + ((wgid % nig) % gsz); u.pn = (wgid % nig) / gsz; return true;
    }
    __device__ __forceinline__ int arow(const Unit& u, int r) const { return u.pm * BM + r; }
};
template <bool GATHER_> struct MoeOrder {
    static constexpr bool GATHER = GATHER_;
    int nunits, G, c, sh, ncol; const int* blke; const int* rtok;
    __device__ bool next(int i, Unit& u) const {
        const int x = c & 7, w = c >> 3, bpr = G >> sh, bpx = bpr >> 3;
        const int blk = i * bpr + x * bpx + (w >> sh), pnl = w & (ncol - 1);
        if (blk * ncol >= nunits) return false;
        const int e = blke[blk];
        u.pm = blk; u.pn = e * ncol + pnl; return true;
    }
    __device__ __forceinline__ int arow(const Unit& u, int r) const { return GATHER_ ? rtok[u.pm * BM + r] : u.pm * BM + r; }
};

__device__ __forceinline__ unsigned cvt_pk_bf16(float lo, float hi) { unsigned r; asm volatile("v_cvt_pk_bf16_f32 %0, %1, %2" : "=v"(r) : "v"(lo), "v"(hi)); return r; }

struct EpiZ {
    static constexpr bool PERM = true;
    bf16_t* O; int ldc;
    __device__ __forceinline__ void operator()(const f32x4 (&acc)[2][2][4][2], const Unit& u, int wr, int wc, int fr, int fq) const {
        const unsigned row0 = u.pm * BM + wr * 64 + fr, col0 = u.pn * BM + wc * 32 + 8 * fq;
        const unsigned b0 = (row0 * (unsigned)ldc + col0) * 2u;
#pragma unroll
        for (int ai = 0; ai < 2; ++ai)
#pragma unroll
            for (int m = 0; m < 4; ++m) { const unsigned rb = b0 + (unsigned)((ai * HALF + m * 16) * 2) * (unsigned)ldc;
#pragma unroll
                for (int bj = 0; bj < 2; ++bj) { const f32x4 v0 = acc[ai][bj][m][0], v1 = acc[ai][bj][m][1];
                    u32x4 w; w.x = cvt_pk_bf16(v0[0], v0[1]); w.y = cvt_pk_bf16(v0[2], v0[3]); w.z = cvt_pk_bf16(v1[0], v1[1]); w.w = cvt_pk_bf16(v1[2], v1[3]);
                    *(u32x4*)((char*)O + (rb + (unsigned)(bj * HALF * 2))) = w; } }
    }
};
template <bool FIRST> struct EpiGate {
    static constexpr bool PERM = true;
    const bf16_t* Z; int gcol; bf16_t* MG;
    __device__ __forceinline__ void operator()(const f32x4 (&acc)[2][2][4][2], const Unit& u, int wr, int wc, int fr, int fq) const {
        const int row0 = u.pm * BM + wr * 64 + fr, col0 = u.pn * BM + wc * 32 + 8 * fq;
#pragma unroll
        for (int ai = 0; ai < 2; ++ai)
#pragma unroll
            for (int m = 0; m < 4; ++m) { const int row = row0 + ai * HALF + m * 16; const bf16_t* zr = Z + (size_t)row * ZLD + gcol + col0; bf16_t* mg = MG + (size_t)row * DM + col0;
#pragma unroll
                for (int bj = 0; bj < 2; ++bj) { const f32x4 v0 = acc[ai][bj][m][0], v1 = acc[ai][bj][m][1];
                    const u32x4 g = *(const u32x4*)(zr + bj * HALF);
                    float r[8];
                    r[0] = sigmoidf_(bflo(g.x)) * v0[0]; r[1] = sigmoidf_(bfhi(g.x)) * v0[1]; r[2] = sigmoidf_(bflo(g.y)) * v0[2]; r[3] = sigmoidf_(bfhi(g.y)) * v0[3];
                    r[4] = sigmoidf_(bflo(g.z)) * v1[0]; r[5] = sigmoidf_(bfhi(g.z)) * v1[1]; r[6] = sigmoidf_(bflo(g.w)) * v1[2]; r[7] = sigmoidf_(bfhi(g.w)) * v1[3];
                    if (!FIRST) { const u32x4 p = *(const u32x4*)(mg + bj * HALF);
                        r[0] += bflo(p.x); r[1] += bfhi(p.x); r[2] += bflo(p.y); r[3] += bfhi(p.y); r[4] += bflo(p.z); r[5] += bfhi(p.z); r[6] += bflo(p.w); r[7] += bfhi(p.w); }
                    u32x4 w; w.x = cvt_pk_bf16(r[0], r[1]); w.y = cvt_pk_bf16(r[2], r[3]); w.z = cvt_pk_bf16(r[4], r[5]); w.w = cvt_pk_bf16(r[6], r[7]);
                    *(u32x4*)(mg + bj * HALF) = w; } }
    }
};
struct EpiRes {
    static constexpr bool PERM = false;
    const float* base; float* out;
    __device__ __forceinline__ void operator()(const f32x4 (&acc)[2][2][4][2], const Unit& u, int wr, int wc, int fr, int fq) const {
        const int row0 = u.pm * BM + wr * 64 + fr, col0 = u.pn * BM + wc * 32 + 4 * fq;
#pragma unroll
        for (int ai = 0; ai < 2; ++ai)
#pragma unroll
            for (int m = 0; m < 4; ++m) { const size_t off = (size_t)(row0 + ai * HALF + m * 16) * DM + col0;
#pragma unroll
                for (int bj = 0; bj < 2; ++bj)
#pragma unroll
                    for (int n = 0; n < 2; ++n) { const f32x4 b = *(const f32x4*)(base + off + bj * HALF + n * 16); *(f32x4*)(out + off + bj * HALF + n * 16) = b + acc[ai][bj][m][n]; }
                asm volatile("" ::: "memory"); }
    }
};
struct EpiSwiglu {
    static constexpr bool PERM = true;
    const float* b1; bf16_t* ACT;
    __device__ __forceinline__ void operator()(const f32x4 (&acc)[2][2][4][2], const Unit& u, int wr, int wc, int fr, int fq) const {
        const int e = u.pn >> 3, pnl = u.pn & 7;
        const int row0 = u.pm * BM + wr * 64 + fr, col0 = pnl * BM + wc * 32 + 8 * fq;
        const float* bp = b1 + (size_t)e * 2048 + col0;
        f32x4 bv[2][2];
#pragma unroll
        for (int bj = 0; bj < 2; ++bj)
#pragma unroll
            for (int n = 0; n < 2; ++n) bv[bj][n] = *(const f32x4*)(bp + bj * HALF + 4 * n);
#pragma unroll
        for (int ai = 0; ai < 2; ++ai)
#pragma unroll
            for (int m = 0; m < 4; ++m) { bf16_t* rowp = ACT + (size_t)(row0 + ai * HALF + m * 16) * DM + (col0 >> 1);
#pragma unroll
                for (int bj = 0; bj < 2; ++bj) { const f32x4 v0 = acc[ai][bj][m][0] + bv[bj][0], v1 = acc[ai][bj][m][1] + bv[bj][1];
                    float o[4];
                    { const float gl = fminf(v0[0], 7.0f), ln = fminf(fmaxf(v0[1], -7.0f), 7.0f); o[0] = gl * sigmoidf_(1.702f * gl) * (ln + 1.0f); }
                    { const float gl = fminf(v0[2], 7.0f), ln = fminf(fmaxf(v0[3], -7.0f), 7.0f); o[1] = gl * sigmoidf_(1.702f * gl) * (ln + 1.0f); }
                    { const float gl = fminf(v1[0], 7.0f), ln = fminf(fmaxf(v1[1], -7.0f), 7.0f); o[2] = gl * sigmoidf_(1.702f * gl) * (ln + 1.0f); }
                    { const float gl = fminf(v1[2], 7.0f), ln = fminf(fmaxf(v1[3], -7.0f), 7.0f); o[3] = gl * sigmoidf_(1.702f * gl) * (ln + 1.0f); }
                    u32x2 w; w.x = cvt_pk_bf16(o[0], o[1]); w.y = cvt_pk_bf16(o[2], o[3]);
                    *(u32x2*)(rowp + bj * (HALF / 2)) = w; } }
    }
};
struct EpiMoe2 {
    static constexpr bool PERM = true;
    const float* b2; const float* rgate; bf16_t* O;
    __device__ __forceinline__ void operator()(const f32x4 (&acc)[2][2][4][2], const Unit& u, int wr, int wc, int fr, int fq) const {
        const int e = u.pn >> 2, pnl = u.pn & 3;
        const int row0 = u.pm * BM + wr * 64 + fr, col0 = pnl * BM + wc * 32 + 8 * fq;
        const float* bp = b2 + (size_t)e * 1024 + col0;
        f32x4 bv[2][2];
#pragma unroll
        for (int bj = 0; bj < 2; ++bj)
#pragma unroll
            for (int n = 0; n < 2; ++n) bv[bj][n] = *(const f32x4*)(bp + bj * HALF + 4 * n);
#pragma unroll
        for (int ai = 0; ai < 2; ++ai)
#pragma unroll
            for (int m = 0; m < 4; ++m) { const int row = row0 + ai * HALF + m * 16; const float gt = rgate[row]; bf16_t* rowp = O + (size_t)row * DM + col0;
#pragma unroll
                for (int bj = 0; bj < 2; ++bj) { const f32x4 v0 = (acc[ai][bj][m][0] + bv[bj][0]) * gt, v1 = (acc[ai][bj][m][1] + bv[bj][1]) * gt;
                    u32x4 w; w.x = cvt_pk_bf16(v0[0], v0[1]); w.y = cvt_pk_bf16(v0[2], v0[3]); w.z = cvt_pk_bf16(v1[0], v1[1]); w.w = cvt_pk_bf16(v1[2], v1[3]);
                    *(u32x4*)(rowp + bj * HALF) = w; } }
    }
};

template <class Epi, class Sched>
__device__ __forceinline__ void gemm_phase(LAS unsigned char* lds, const Gemm g, const Sched& S, const Epi& E) {
    const int tid = threadIdx.x, wid = __builtin_amdgcn_readfirstlane(tid >> 6), lane = tid & 63, wr = wid >> 2, wc = wid & 3, fr = lane & 15, fq = lane >> 4;
    const int K = g.K, nt = K / BK;
    constexpr bool GA = Sched::GATHER;
    unsigned voffA[2], voffB[2];
#pragma unroll
    for (int i = 0; i < 2; ++i) { int R, C; stage_rc(tid * 16 + i * 8192, R, C); const int Rb = Epi::PERM ? ((R & ~31) + perm32(R & 31)) : R;
        voffA[i] = GA ? (unsigned)C * 2u : (unsigned)(R * K + C) * 2u; voffB[i] = (unsigned)(Rb * K + C) * 2u; }
    const size_t kstep = (size_t)(BK * 2);
    const size_t hstep = (size_t)HALF * K * 2;
    const size_t tstep = 2 * hstep;
    const unsigned ldsw = (unsigned)wid * 1024u;
    const int aoff = lds_byte(wr * 64 + fr, fq * 8), boff = lds_byte(wc * 32 + fr, fq * 8);
#define PG8_SA(b, h) (((b) * 2 + (h)) * HTB)
#define PG8_SB(b, h) ((4 + (b) * 2 + (h)) * HTB)
#define PG8_STAGE(bufoff, gbase, voff) do { _Pragma("unroll") for (int _i = 0; _i < 2; ++_i) \
        __builtin_amdgcn_global_load_lds((const unsigned*)((const char*)(gbase) + (voff)[_i]), (LAS unsigned*)(lds + (bufoff) + ldsw + _i * 8192), 16, 0, 0); } while (0)
#define PG8_STAGEA(bufoff, pA, kb, h) do { if constexpr (GA) { \
            __builtin_amdgcn_global_load_lds((const unsigned*)((const char*)g.A + (kb) + og[h][0]), (LAS unsigned*)(lds + (bufoff) + ldsw), 16, 0, 0); \
            __builtin_amdgcn_global_load_lds((const unsigned*)((const char*)g.A + (kb) + og[h][1]), (LAS unsigned*)(lds + (bufoff) + ldsw + 8192), 16, 0, 0); \
        } else { PG8_STAGE(bufoff, (pA) + (h) * hstep, voffA); } } while (0)
#define PG8_ROWS(u, dst) do { _Pragma("unroll") for (int _h = 0; _h < 2; ++_h) _Pragma("unroll") for (int _i = 0; _i < 2; ++_i) { int R_, C_; stage_rc(tid * 16 + _i * 8192, R_, C_); \
        dst[_h][_i] = (unsigned)S.arow(u, _h * HALF + R_) * (unsigned)(K * 2) + voffA[_i]; } } while (0)
#define PG8_LDA(dst, b, h) do { _Pragma("unroll") for (int m = 0; m < 4; ++m) _Pragma("unroll") for (int k = 0; k < 2; ++k) dst[m][k] = *(const LAS bf16x8*)(lds + PG8_SA(b, h) + aoff + m * 2048 + k * 1024); } while (0)
#define PG8_LDB(dst, b, h) do { _Pragma("unroll") for (int n = 0; n < 2; ++n) _Pragma("unroll") for (int k = 0; k < 2; ++k) dst[n][k] = *(const LAS bf16x8*)(lds + PG8_SB(b, h) + boff + n * 2048 + k * 1024); } while (0)
#define PG8_MMA(ai, bj, At, Bt) do { __builtin_amdgcn_s_setprio(1); _Pragma("unroll") for (int m = 0; m < 4; ++m) _Pragma("unroll") for (int n = 0; n < 2; ++n) _Pragma("unroll") for (int k = 0; k < 2; ++k) \
        acc[ai][bj][m][n] = __builtin_amdgcn_mfma_f32_16x16x32_bf16(Bt[n][k], At[m][k], acc[ai][bj][m][n], 0, 0, 0); __builtin_amdgcn_s_setprio(0); } while (0)
#define PG8_WAIT_V(n) asm volatile("s_waitcnt vmcnt(" #n ")" ::: "memory")
#define PG8_WAIT_L(n) asm volatile("s_waitcnt lgkmcnt(" #n ")" ::: "memory")
#define PG8_BAR __builtin_amdgcn_s_barrier()
#define PG8_SCHED __builtin_amdgcn_sched_barrier(0)
    Unit cur, nxt; int ui = 0;
    if (!S.next(0, cur)) return;
    f32x4 acc[2][2][4][2];
#pragma unroll
    for (int a = 0; a < 2; ++a)
#pragma unroll
        for (int b = 0; b < 2; ++b)
#pragma unroll
            for (int m = 0; m < 4; ++m)
#pragma unroll
                for (int n = 0; n < 2; ++n) acc[a][b][m][n] = (f32x4){0.f, 0.f, 0.f, 0.f};
    bf16x8 At[4][2], B0[2][2], B1[2][2];
    unsigned og[2][2], ogn[2][2];
    const char* cA = GA ? (const char*)nullptr : (const char*)g.A + (size_t)cur.pm * tstep; const char* cB = (const char*)g.Bt + (size_t)cur.pn * tstep;
    if constexpr (GA) { PG8_ROWS(cur, og); }
    PG8_STAGE(PG8_SB(0, 0), cB, voffB); PG8_STAGE(PG8_SB(0, 1), cB + hstep, voffB); PG8_STAGEA(PG8_SA(0, 0), cA, 0, 0); PG8_STAGEA(PG8_SA(0, 1), cA, 0, 1);
    if (wr == 1) PG8_BAR;
    PG8_WAIT_V(2); PG8_BAR;
    PG8_STAGE(PG8_SB(1, 0), cB + kstep, voffB); PG8_STAGEA(PG8_SA(1, 0), cA + kstep, (unsigned)(BK * 2), 0); PG8_STAGE(PG8_SB(1, 1), cB + hstep + kstep, voffB);
    PG8_WAIT_V(6); PG8_BAR;
    for (;;) {
        const bool has_next = S.next(ui + 1, nxt);
        const char* nA = GA ? (const char*)nullptr : (has_next ? (const char*)g.A + (size_t)nxt.pm * tstep : cA); const char* nB = has_next ? (const char*)g.Bt + (size_t)nxt.pn * tstep : cB;
        if constexpr (GA) { if (has_next) { PG8_ROWS(nxt, ogn); } else {
#pragma unroll
            for (int _h = 0; _h < 2; ++_h)
#pragma unroll
                for (int _i = 0; _i < 2; ++_i) ogn[_h][_i] = og[_h][_i]; } }
        for (int t = 0; t < nt; t += 2) {
            const bool last = (t == nt - 2);
            const char* a1 = cA + (size_t)(t + 1) * kstep;
            const char* a2 = last ? nA : cA + (size_t)(t + 2) * kstep; const char* b2 = last ? nB : cB + (size_t)(t + 2) * kstep;
            const char* a3 = a2 + kstep; const char* b3 = b2 + kstep;
            const unsigned ka1 = (unsigned)(t + 1) * (unsigned)(BK * 2), ka2 = last ? 0u : (unsigned)(t + 2) * (unsigned)(BK * 2), ka3 = ka2 + (unsigned)(BK * 2);
            PG8_LDB(B0, 0, 0); PG8_LDB(B1, 0, 1); PG8_SCHED; PG8_LDA(At, 0, 0); PG8_STAGEA(PG8_SA(1, 1), a1, ka1, 1);
            if constexpr (GA) { if (last) {
#pragma unroll
                for (int _h = 0; _h < 2; ++_h)
#pragma unroll
                    for (int _i = 0; _i < 2; ++_i) og[_h][_i] = ogn[_h][_i]; } }
            PG8_WAIT_V(8); PG8_WAIT_L(0); PG8_BAR; PG8_MMA(0, 0, At, B0); PG8_MMA(0, 1, At, B1); PG8_BAR; PG8_SCHED;
            PG8_LDA(At, 0, 1); PG8_STAGE(PG8_SB(0, 0), b2, voffB); PG8_STAGE(PG8_SB(0, 1), b2 + hstep, voffB); PG8_STAGEA(PG8_SA(0, 0), a2, ka2, 0);
            PG8_WAIT_V(8); PG8_WAIT_L(0); PG8_BAR; PG8_MMA(1, 0, At, B0); PG8_MMA(1, 1, At, B1); PG8_BAR; PG8_SCHED;
            PG8_LDB(B0, 1, 0); PG8_LDB(B1, 1, 1); PG8_SCHED; PG8_LDA(At, 1, 0); PG8_STAGEA(PG8_SA(0, 1), a2, ka2, 1);
            PG8_WAIT_V(8); PG8_WAIT_L(0); PG8_BAR; PG8_MMA(0, 0, At, B0); PG8_MMA(0, 1, At, B1); PG8_BAR; PG8_SCHED;
            PG8_LDA(At, 1, 1); PG8_STAGE(PG8_SB(1, 0), b3, voffB); PG8_STAGE(PG8_SB(1, 1), b3 + hstep, voffB); PG8_STAGEA(PG8_SA(1, 0), a3, ka3, 0);
            PG8_WAIT_V(8); PG8_WAIT_L(0); PG8_BAR; PG8_MMA(1, 0, At, B0); PG8_MMA(1, 1, At, B1); PG8_BAR; PG8_SCHED;
        }
        if (wr == 0) PG8_BAR;
        E(acc, cur, wr, wc, fr, fq);
        if (!has_next) break;
#pragma unroll
        for (int a = 0; a < 2; ++a)
#pragma unroll
            for (int b = 0; b < 2; ++b)
#pragma unroll
                for (int m = 0; m < 4; ++m)
#pragma unroll
                    for (int n = 0; n < 2; ++n) acc[a][b][m][n] = (f32x4){0.f, 0.f, 0.f, 0.f};
        cur = nxt; cA = nA; cB = nB; ++ui;
        if (wr == 1) PG8_BAR;
    }
    PG8_WAIT_V(0);
    PG8_BAR;
#undef PG8_SA
#undef PG8_SB
#undef PG8_STAGE
#undef PG8_STAGEA
#undef PG8_ROWS
#undef PG8_LDA
#undef PG8_LDB
#undef PG8_MMA
#undef PG8_WAIT_V
#undef PG8_WAIT_L
#undef PG8_BAR
#undef PG8_SCHED
}
}

struct Args { const float* in[28]; float* out; unsigned char* ws; int ph_lo, ph_hi; };
enum { I_X = 0, I_NMG, I_WIN, I_GUP, I_GBIAS, I_GNG, I_MU, I_W0, I_W2, I_A0, I_A2, I_G2, I_KK, I_KA, I_RK, I_LNW, I_LNB, I_WA, I_WB, I_WO, I_NFG, I_RW, I_RB, I_EW1, I_EB1, I_EW2, I_EB2, I_NFIN };

__device__ __forceinline__ int win_orig_col(int c) {
    if (c < 2048) return c;
    if (c < 3072) return 2064 + (c - 2048);
    if (c < 6144) return 3088 + (c - 3072);
    if (c < 8192) return 6416 + (c - 6144);
    if (c < 8448) return 6160 + (c - 8192);
    if (c < 8464) return 2048 + (c - 8448);
    return -1;
}
__device__ __forceinline__ void tr_tile(const float* src, int ldsrc, bf16_t* dst, int n0, int k0, bool is_win, LAS float* tile) {
    const int tid = threadIdx.x, tx = tid & 63, ty = tid >> 6;
    const int c = n0 + tx, oc = is_win ? win_orig_col(c) : c;
#pragma unroll
    for (int kk = ty; kk < 64; kk += 8) tile[kk * 65 + tx] = oc >= 0 ? src[(size_t)(k0 + kk) * ldsrc + oc] : 0.0f;
    __syncthreads();
    const int kp = tid & 31, nn0 = tid >> 5;
#pragma unroll
    for (int nn = nn0; nn < 64; nn += 16) ((unsigned*)dst)[((size_t)(n0 + nn) * 1024 + k0) / 2 + kp] = pk2(tile[(2 * kp) * 65 + nn], tile[(2 * kp + 1) * 65 + nn]);
    __syncthreads();
}
constexpr int PRO_T3 = 136 * 16 + 768, PRO_T5 = PRO_T3 + 32 * 32 * 16 + 32 * 16 * 16;
__device__ __forceinline__ void prologue_phase(const Args& a, LAS unsigned char* lds, int bid, int nb, int t_lo, int t_hi) {
    LAS float* tile = (LAS float*)lds;
    unsigned char* ws = a.ws;
    constexpr int T0 = 136 * 16, T1 = T0 + 256, T2 = T1 + 256, T3 = T2 + 256, T4 = T3 + 32 * 32 * 16, T5 = T4 + 32 * 16 * 16;
    for (int t = t_lo + bid; t < t_hi; t += nb) {
        if (t < T0) { tr_tile(a.in[I_WIN], 8464, (bf16_t*)(ws + WS_WIN), (t >> 4) * 64, (t & 15) * 64, true, tile); }
        else if (t < T1) { const int q = t - T0; tr_tile(a.in[I_WA], 1024, (bf16_t*)(ws + WS_WA), (q >> 4) * 64, (q & 15) * 64, false, tile); }
        else if (t < T2) { const int q = t - T1; tr_tile(a.in[I_WB], 1024, (bf16_t*)(ws + WS_WB), (q >> 4) * 64, (q & 15) * 64, false, tile); }
        else if (t < T3) { const int q = t - T2; tr_tile(a.in[I_WO], 1024, (bf16_t*)(ws + WS_WO), (q >> 4) * 64, (q & 15) * 64, false, tile); }
        else if (t < T4) { const int q = t - T3, e = q >> 9, r = q & 511; tr_tile(a.in[I_EW1] + (size_t)e * 1024 * 2048, 2048, (bf16_t*)(ws + WS_W1) + (size_t)e * 2048 * 1024, (r >> 4) * 64, (r & 15) * 64, false, tile); }
        else { const int q = t - T4, e = q >> 8, r = q & 255; tr_tile(a.in[I_EW2] + (size_t)e * 1024 * 1024, 1024, (bf16_t*)(ws + WS_W2) + (size_t)e * 1024 * 1024, (r >> 4) * 64, (r & 15) * 64, false, tile); }
    }
}

__device__ __forceinline__ void rmsnorm_phase(const float* x, const float* gain, bf16_t* out, int bid, int nb) {
    const int lane = threadIdx.x & 63, gw = bid * 8 + (threadIdx.x >> 6), nw = nb * 8;
    for (int row = gw; row < TH; row += nw) {
        const f32x4* xr = (const f32x4*)(x + (size_t)row * DM);
        f32x4 v[4]; float ss = 0.f;
#pragma unroll
        for (int i = 0; i < 4; ++i) { v[i] = xr[i * 64 + lane]; ss += v[i][0] * v[i][0] + v[i][1] * v[i][1] + v[i][2] * v[i][2] + v[i][3] * v[i][3]; }
        ss = wave_sum(ss);
        const float rs = rsqrtf(ss * (1.0f / 1024.0f) + 1e-6f);
#pragma unroll
        for (int i = 0; i < 4; ++i) { const f32x4 g = ((const f32x4*)gain)[i * 64 + lane];
            u32x2 w; w.x = pk2(v[i][0] * rs * g[0], v[i][1] * rs * g[1]); w.y = pk2(v[i][2] * rs * g[2], v[i][3] * rs * g[3]);
            *(u32x2*)(out + (size_t)row * DM + (i * 64 + lane) * 4) = w; }
    }
}

__device__ __forceinline__ void rwkv_unit(const Args& a, int chain, LAS unsigned char* lds) {
    const int tid = threadIdx.x, lane = tid & 63, wv = tid >> 6;
    const int b = chain >> 4, h = chain & 15;
    const bf16_t* Z = (const bf16_t*)(a.ws + WS_Z); bf16_t* YB = (bf16_t*)(a.ws + WS_YB);
    LAS float* Rr = (LAS float*)(lds + 0); LAS float* Ww = (LAS float*)(lds + 16384); LAS float* Kk = (LAS float*)(lds + 32768); LAS float* Vv = (LAS float*)(lds + 49152);
    LAS float* KKn = (LAS float*)(lds + 65536); LAS float* Bb = (LAS float*)(lds + 81920); LAS float* Yy = (LAS float*)(lds + 98304);
    LAS bf16_t* XW = (LAS bf16_t*)(lds + 114688); LAS bf16_t* XA = (LAS bf16_t*)(lds + 122880); LAS bf16_t* XG = (LAS bf16_t*)(lds + 131072); LAS float* BON = (LAS float*)(lds + 147456);
    const float* mu = a.in[I_MU];
    float s[16];
#pragma unroll
    for (int j = 0; j < 16; ++j) s[j] = 0.f;
    for (int n = 0; n < 64; ++n) {
        const int t0 = b * SEQ + n * 64;
        for (int task = tid; task < 64 * 56; task += 512) {
            const int t = task / 56, gq = task - t * 56;
            int zc, mi;
            if (gq < 8) { zc = ZR + h * 64 + gq * 8; mi = h * 64 + gq * 8; }
            else if (gq < 16) { zc = ZK2 + h * 64 + (gq - 8) * 8; mi = 1024 + h * 64 + (gq - 8) * 8; }
            else if (gq < 24) { zc = ZV2 + h * 64 + (gq - 16) * 8; mi = 2048 + h * 64 + (gq - 16) * 8; }
            else if (gq < 32) { zc = ZXW + (gq - 24) * 8; mi = 3072 + (gq - 24) * 8; }
            else if (gq < 40) { zc = ZXA + (gq - 32) * 8; mi = 3136 + (gq - 32) * 8; }
            else { zc = ZXG + (gq - 40) * 8; mi = 3200 + (gq - 40) * 8; }
            const u32x4 cu = *(const u32x4*)(Z + (size_t)(t0 + t) * ZLD + zc);
            u32x4 pv = (u32x4){0u, 0u, 0u, 0u};
            if (!(n == 0 && t == 0)) pv = *(const u32x4*)(Z + (size_t)(t0 + t - 1) * ZLD + zc);
            const f32x4 m0 = *(const f32x4*)(mu + mi), m1 = *(const f32x4*)(mu + mi + 4);
            float u[8];
            { float c;
              c = bflo(cu.x); u[0] = c + m0[0] * (bflo(pv.x) - c); c = bfhi(cu.x); u[1] = c + m0[1] * (bfhi(pv.x) - c);
              c = bflo(cu.y); u[2] = c + m0[2] * (bflo(pv.y) - c); c = bfhi(cu.y); u[3] = c + m0[3] * (bfhi(pv.y) - c);
              c = bflo(cu.z); u[4] = c + m1[0] * (bflo(pv.z) - c); c = bfhi(cu.z); u[5] = c + m1[1] * (bfhi(pv.z) - c);
              c = bflo(cu.w); u[6] = c + m1[2] * (bflo(pv.w) - c); c = bfhi(cu.w); u[7] = c + m1[3] * (bfhi(pv.w) - c); }
            if (gq < 24) { LAS float* dst = (gq < 8 ? Rr : (gq < 16 ? Kk : Vv)) + t * 64 + (gq & 7) * 8;
#pragma unroll
                for (int q = 0; q < 8; ++q) dst[q] = u[q]; }
            else if (gq < 32) { LAS bf16_t* dst = XW + t * 64 + (gq - 24) * 8;
#pragma unroll
                for (int q = 0; q < 8; ++q) dst[q] = f2bf(tanhf(u[q])); }
            else if (gq < 40) { LAS bf16_t* dst = XA + t * 64 + (gq - 32) * 8;
#pragma unroll
                for (int q = 0; q < 8; ++q) dst[q] = f2bf(u[q]); }
            else { LAS bf16_t* dst = XG + t * 128 + (gq - 40) * 8;
#pragma unroll
                for (int q = 0; q < 8; ++q) dst[q] = f2bf(sigmoidf_(u[q])); }
        }
        __syncthreads();
        {
            const int j = lane, hj = h * 64 + j;
            float aw[8], aa[8];
            const float w0v = a.in[I_W0][hj], a0v = a.in[I_A0][hj];
#pragma unroll
            for (int tt = 0; tt < 8; ++tt) { aw[tt] = w0v; aa[tt] = a0v; }
            const float* w2 = a.in[I_W2] + hj; const float* a2 = a.in[I_A2] + hj;
            for (int m = 0; m < 64; m += 2) {
                const float w2a = w2[(size_t)m * 1024], w2b = w2[(size_t)(m + 1) * 1024], a2a = a2[(size_t)m * 1024], a2b = a2[(size_t)(m + 1) * 1024];
#pragma unroll
                for (int tt = 0; tt < 8; ++tt) { const int t = wv * 8 + tt;
                    const unsigned xw = *(const LAS unsigned*)(XW + t * 64 + m), xa = *(const LAS unsigned*)(XA + t * 64 + m);
                    aw[tt] += bflo(xw) * w2a + bfhi(xw) * w2b; aa[tt] += bflo(xa) * a2a + bfhi(xa) * a2b; }
            }
            const float kkw = a.in[I_KK][hj], kaw = a.in[I_KA][hj], rkw = a.in[I_RK][hj];
#pragma unroll
            for (int tt = 0; tt < 8; ++tt) { const int t = wv * 8 + tt;
                const float y = -aw[tt];
                const float sp = fmaxf(y, 0.f) + log1pf(__expf(-fabsf(y)));
                const float wlog = -sp - 0.5f;
                const float decay = __expf(-__expf(wlog));
                const float asig = sigmoidf_(aa[tt]);
                const float kraw = Kk[t * 64 + j], rr = Rr[t * 64 + j];
                const float kkr = kraw * kkw;
                const float ss = wave_sum(kkr * kkr);
                const float kk = kkr / fmaxf(sqrtf(ss), 1e-12f);
                const float kmod = kraw * (1.0f + (asig - 1.0f) * kaw);
                const float bon = wave_sum(rr * kmod * rkw);
                Ww[t * 64 + j] = decay; Kk[t * 64 + j] = kmod; KKn[t * 64 + j] = kk; Bb[t * 64 + j] = kk * asig;
                if (lane == 0) BON[t] = bon; }
        }
        __syncthreads();
        if (wv < 4) {
            const int i = wv * 16 + (lane >> 2), j0 = (lane & 3) * 16;
            for (int t = 0; t < 64; ++t) {
                float av[16], wv_[16], bv[16], kv[16], rv[16];
#pragma unroll
                for (int q = 0; q < 4; ++q) {
                    const f32x4 x0 = *(const LAS f32x4*)(KKn + t * 64 + j0 + q * 4), x1 = *(const LAS f32x4*)(Ww + t * 64 + j0 + q * 4), x2 = *(const LAS f32x4*)(Bb + t * 64 + j0 + q * 4),
                                x3 = *(const LAS f32x4*)(Kk + t * 64 + j0 + q * 4), x4 = *(const LAS f32x4*)(Rr + t * 64 + j0 + q * 4);
#pragma unroll
                    for (int r = 0; r < 4; ++r) { av[q * 4 + r] = -x0[r]; wv_[q * 4 + r] = x1[r]; bv[q * 4 + r] = x2[r]; kv[q * 4 + r] = x3[r]; rv[q * 4 + r] = x4[r]; }
                }
                const float vi = Vv[t * 64 + i];
                float sa = 0.f;
#pragma unroll
                for (int q = 0; q < 16; ++q) sa += s[q] * av[q];
                sa += __shfl_xor(sa, 1); sa += __shfl_xor(sa, 2);
                float y = 0.f;
#pragma unroll
                for (int q = 0; q < 16; ++q) { s[q] = s[q] * wv_[q] + sa * bv[q] + vi * kv[q]; y += s[q] * rv[q]; }
                y += __shfl_xor(y, 1); y += __shfl_xor(y, 2);
                if ((lane & 3) == 0) Yy[t * 64 + i] = y;
            }
        }
        __syncthreads();
        {
            const int i = lane, hi = h * 64 + i;
            float ag[8];
#pragma unroll
            for (int tt = 0; tt < 8; ++tt) ag[tt] = 0.f;
            const float* g2 = a.in[I_G2] + hi;
            for (int m = 0; m < 128; m += 2) {
                const float ga = g2[(size_t)m * 1024], gb = g2[(size_t)(m + 1) * 1024];
#pragma unroll
                for (int tt = 0; tt < 8; ++tt) { const unsigned xg = *(const LAS unsigned*)(XG + (wv * 8 + tt) * 128 + m); ag[tt] += bflo(xg) * ga + bfhi(xg) * gb; }
            }
            const float lw = a.in[I_LNW][hi], lb = a.in[I_LNB][hi];
#pragma unroll
            for (int tt = 0; tt < 8; ++tt) { const int t = wv * 8 + tt;
                const float y = Yy[t * 64 + i];
                const float mean = wave_sum(y) * (1.0f / 64.0f);
                const float d = y - mean;
                const float var = wave_sum(d * d) * (1.0f / 64.0f);
                float yn = d * rsqrtf(var + 64e-5f) * lw + lb;
                yn += BON[t] * Vv[t * 64 + i];
                YB[(size_t)(t0 + t) * DM + hi] = f2bf(yn * ag[tt]); }
        }
        __syncthreads();
    }
}

constexpr int RL = 72;
constexpr int RLF = 68;
constexpr int RO_SB0 = 0, RO_SB1 = 9216, RO_GT = 18432, RO_BON = 27648, RO_GC = 27904, RO_WTOT = 28160, RO_MUL = 30208  , RO_LAST = 32000  ;
constexpr int RO_AM = 33280, RO_RM = RO_AM + 9216, RO_BM = RO_RM + 9216, RO_KM = RO_BM + 9216, RO_BH = RO_KM + 9216, RO_KH = RO_BH + 9216, RO_VT = RO_KH + 9216;
constexpr int RO_E = RO_VT + 9216;
constexpr int RO_XW = RO_E, RO_XA = RO_E + 9216, RO_XG = RO_E + 18432;
constexpr int RO_WPT = RO_E, RO_APT = RO_E + 17408;
constexpr int RO_RRB = RO_E + 35840, RO_KRB = RO_RRB + 9216, RO_VRB = RO_KRB + 9216;
constexpr int RO_LF = RO_E, RO_LAK = RO_E + 17408, RO_LRB = RO_LAK + 9216, RO_LRK = RO_LRB + 9216, RO_YY = RO_LRK + 9216;
constexpr int RO_ZT = RO_YY, RO_W = RO_YY + 6912, RO_X1T = RO_BM, RO_UT = RO_KM;
static_assert(RO_YY + 17408 <= RO_VRB + 9216 && RO_VRB + 9216 <= MISC_OFF, "rwkv LDS map");

__device__ __forceinline__ bf16x8 lds_frag(const LAS bf16_t* base, int row0, int ld, int kofs, int lane) {
    return *(const LAS bf16x8*)(base + (row0 + (lane & 15)) * ld + kofs + (lane >> 4) * 8);
}
#define MFMA16(a, b, c) __builtin_amdgcn_mfma_f32_16x16x32_bf16(a, b, c, 0, 0, 0)

#define LDS_BAR() do { asm volatile("s_waitcnt lgkmcnt(0)" ::: "memory"); __builtin_amdgcn_s_barrier(); asm volatile("" ::: "memory"); } while (0)
__device__ __forceinline__ int rw_zcol(int gq, int h) {
    return gq < 8 ? ZR + h * 64 + gq * 8 : gq < 16 ? ZK2 + h * 64 + (gq - 8) * 8 : gq < 24 ? ZV2 + h * 64 + (gq - 16) * 8 : gq < 32 ? ZXW + (gq - 24) * 8 : gq < 40 ? ZXA + (gq - 32) * 8 : ZXG + (gq - 40) * 8;
}
__device__ __forceinline__ int rw_mucol(int gq, int h) {
    return gq < 8 ? h * 64 + gq * 8 : gq < 16 ? 1024 + h * 64 + (gq - 8) * 8 : gq < 24 ? 2048 + h * 64 + (gq - 16) * 8 : gq < 32 ? 3072 + (gq - 24) * 8 : gq < 40 ? 3136 + (gq - 32) * 8 : 3200 + (gq - 40) * 8;
}
__device__ __forceinline__ void rwkv_fast_unit(const Args& a, int chain, LAS unsigned char* lds) {
    const int tid0 = threadIdx.x, lane0 = tid0 & 63, wv = __builtin_amdgcn_readfirstlane(tid0 >> 6);
    const int b = chain >> 4, h = chain & 15;
#define RW_LANES int lane = lane0; asm volatile("" : "+v"(lane)); const int fr = lane & 15, fq = lane >> 4, tid = wv * 64 + lane; (void)fr; (void)fq; (void)tid;
    const bf16_t* Z = (const bf16_t*)(a.ws + WS_Z); bf16_t* YB = (bf16_t*)(a.ws + WS_YB);
    const float* mu = a.in[I_MU];
    LAS bf16_t* GT = (LAS bf16_t*)(lds + RO_GT); LAS float* BON = (LAS float*)(lds + RO_BON); LAS float* GC = (LAS float*)(lds + RO_GC); LAS float* WTOT = (LAS float*)(lds + RO_WTOT);
    LAS bf16_t* AM = (LAS bf16_t*)(lds + RO_AM); LAS bf16_t* RM = (LAS bf16_t*)(lds + RO_RM); LAS bf16_t* BM = (LAS bf16_t*)(lds + RO_BM); LAS bf16_t* KM = (LAS bf16_t*)(lds + RO_KM);
    LAS bf16_t* BH = (LAS bf16_t*)(lds + RO_BH); LAS bf16_t* KH = (LAS bf16_t*)(lds + RO_KH); LAS bf16_t* VT = (LAS bf16_t*)(lds + RO_VT);
    LAS bf16_t* XW = (LAS bf16_t*)(lds + RO_XW); LAS bf16_t* XA = (LAS bf16_t*)(lds + RO_XA); LAS bf16_t* XG = (LAS bf16_t*)(lds + RO_XG);
    LAS float* WPT = (LAS float*)(lds + RO_WPT); LAS float* APT = (LAS float*)(lds + RO_APT);
    LAS bf16_t* RRB = (LAS bf16_t*)(lds + RO_RRB); LAS bf16_t* KRB = (LAS bf16_t*)(lds + RO_KRB); LAS bf16_t* VRB = (LAS bf16_t*)(lds + RO_VRB);
    LAS float* LF = (LAS float*)(lds + RO_LF); LAS bf16_t* LAK = (LAS bf16_t*)(lds + RO_LAK); LAS bf16_t* LRB = (LAS bf16_t*)(lds + RO_LRB); LAS bf16_t* LRK = (LAS bf16_t*)(lds + RO_LRK);
    LAS float* YY = (LAS float*)(lds + RO_YY); LAS bf16_t* Wm = (LAS bf16_t*)(lds + RO_W);
    LAS bf16_t* X1T = (LAS bf16_t*)(lds + RO_X1T); LAS bf16_t* UT = (LAS bf16_t*)(lds + RO_UT); LAS bf16_t* ZT = (LAS bf16_t*)(lds + RO_ZT);

    bf16x8 fw[2], fa[2], fg[4]; float w0v, a0v, kkw, kaw, rkw, lnw, lnb; f32x4 st[2]; u32x4 pre[7];
    const int nt_ = wv & 3;
    {
    RW_LANES
    const int hjf = h * 64 + nt_ * 16 + fr;
#pragma unroll
    for (int ks = 0; ks < 2; ++ks) { unsigned pw[4], pa[4];
#pragma unroll
        for (int q = 0; q < 4; ++q) { const int m = ks * 32 + fq * 8 + q * 2;
            pw[q] = pk2(a.in[I_W2][(size_t)m * 1024 + hjf], a.in[I_W2][(size_t)(m + 1) * 1024 + hjf]); pa[q] = pk2(a.in[I_A2][(size_t)m * 1024 + hjf], a.in[I_A2][(size_t)(m + 1) * 1024 + hjf]); }
        u32x4 t; t.x = pw[0]; t.y = pw[1]; t.z = pw[2]; t.w = pw[3]; fw[ks] = __builtin_bit_cast(bf16x8, t);
        t.x = pa[0]; t.y = pa[1]; t.z = pa[2]; t.w = pa[3]; fa[ks] = __builtin_bit_cast(bf16x8, t); }
#pragma unroll
    for (int ks = 0; ks < 4; ++ks) { unsigned pg[4];
#pragma unroll
        for (int q = 0; q < 4; ++q) { const int m = ks * 32 + fq * 8 + q * 2; pg[q] = pk2(a.in[I_G2][(size_t)m * 1024 + hjf], a.in[I_G2][(size_t)(m + 1) * 1024 + hjf]); }
        u32x4 t; t.x = pg[0]; t.y = pg[1]; t.z = pg[2]; t.w = pg[3]; fg[ks] = __builtin_bit_cast(bf16x8, t); }
    const int hj = h * 64 + lane;
    w0v = a.in[I_W0][hj]; a0v = a.in[I_A0][hj]; kkw = a.in[I_KK][hj]; kaw = a.in[I_KA][hj]; rkw = a.in[I_RK][hj]; lnw = a.in[I_LNW][hj]; lnb = a.in[I_LNB][hj];
    st[0] = (f32x4){0.f, 0.f, 0.f, 0.f}; st[1] = st[0];
    for (int idx = tid; idx < 64 * RL / 2; idx += 512) ((LAS unsigned*)(lds + RO_SB0))[idx] = 0u;
    if (tid < 448) { const int gq = tid >> 3; ((LAS float*)(lds + RO_MUL))[tid] = mu[rw_mucol(gq, h) + (tid & 7)]; }
    if (tid < 224) ((LAS unsigned*)(lds + RO_LAST))[tid] = 0u;
#pragma unroll
    for (int i = 0; i < 7; ++i) pre[i] = *(const u32x4*)(Z + (size_t)(b * SEQ + lane) * ZLD + rw_zcol(wv + 8 * i, h));
    }
    LDS_BAR();

    for (int n = 0; n < 64; ++n) {
        const int t0 = b * SEQ + n * 64;
        LAS bf16_t* SB = (LAS bf16_t*)(lds + ((n & 1) ? RO_SB1 : RO_SB0)); LAS bf16_t* SBn = (LAS bf16_t*)(lds + ((n & 1) ? RO_SB0 : RO_SB1)); LAS bf16_t* WTR = SBn;
        {
        RW_LANES
        LAS float* MUL = (LAS float*)(lds + RO_MUL); LAS u32x4* LAST = (LAS u32x4*)(lds + RO_LAST);
        const int t = lane;
#pragma unroll
        for (int i = 0; i < 7; ++i) {
            const int gq = wv + 8 * i;
            const u32x4 cu = pre[i];
            u32x4 pv; pv.x = __shfl_up(cu.x, 1); pv.y = __shfl_up(cu.y, 1); pv.z = __shfl_up(cu.z, 1); pv.w = __shfl_up(cu.w, 1);
            if (lane == 0) pv = LAST[gq];
            if (lane == 63) LAST[gq] = cu;
            if (n + 1 < 64) pre[i] = *(const u32x4*)(Z + (size_t)(t0 + 64 + lane) * ZLD + rw_zcol(gq, h));
            const f32x4 m0 = *(const LAS f32x4*)(MUL + gq * 8), m1 = *(const LAS f32x4*)(MUL + gq * 8 + 4);
            float u[8];
            { float c;
              c = bflo(cu.x); u[0] = c + m0[0] * (bflo(pv.x) - c); c = bfhi(cu.x); u[1] = c + m0[1] * (bfhi(pv.x) - c);
              c = bflo(cu.y); u[2] = c + m0[2] * (bflo(pv.y) - c); c = bfhi(cu.y); u[3] = c + m0[3] * (bfhi(pv.y) - c);
              c = bflo(cu.z); u[4] = c + m1[0] * (bflo(pv.z) - c); c = bfhi(cu.z); u[5] = c + m1[1] * (bfhi(pv.z) - c);
              c = bflo(cu.w); u[6] = c + m1[2] * (bflo(pv.w) - c); c = bfhi(cu.w); u[7] = c + m1[3] * (bfhi(pv.w) - c); }
            LAS bf16_t* dst;
            if (gq < 8) dst = RRB + t * RL + gq * 8;
            else if (gq < 16) dst = KRB + t * RL + (gq - 8) * 8;
            else if (gq < 24) dst = VRB + t * RL + (gq - 16) * 8;
            else if (gq < 32) { dst = XW + t * RL + (gq - 24) * 8;
#pragma unroll
                for (int q = 0; q < 8; ++q) u[q] = tanhf_(u[q]); }
            else if (gq < 40) dst = XA + t * RL + (gq - 32) * 8;
            else { dst = XG + t * 136 + (gq - 40) * 8;
#pragma unroll
                for (int q = 0; q < 8; ++q) u[q] = sigmoidf_(u[q]); }
            u32x4 w; w.x = pk2(u[0], u[1]); w.y = pk2(u[2], u[3]); w.z = pk2(u[4], u[5]); w.w = pk2(u[6], u[7]);
            *(LAS u32x4*)dst = w;
        }
        }
        LDS_BAR();
        {
        RW_LANES
        {
            f32x4 cw[2], ca[2], cg[2];
            bf16x8 xw[2][2], xa[2][2], xg[2][4];
#pragma unroll
            for (int q = 0; q < 2; ++q) { const int mt = (wv >> 2) + 2 * q;
#pragma unroll
                for (int ks = 0; ks < 2; ++ks) { xw[q][ks] = lds_frag(XW, mt * 16, RL, ks * 32, lane); xa[q][ks] = lds_frag(XA, mt * 16, RL, ks * 32, lane); }
#pragma unroll
                for (int ks = 0; ks < 4; ++ks) xg[q][ks] = lds_frag(XG, mt * 16, 136, ks * 32, lane); }
            LDS_BAR();
#pragma unroll
            for (int q = 0; q < 2; ++q) { const int mt = (wv >> 2) + 2 * q;
                cw[q] = (f32x4){0.f, 0.f, 0.f, 0.f}; ca[q] = cw[q]; cg[q] = cw[q];
#pragma unroll
                for (int ks = 0; ks < 2; ++ks) { cw[q] = MFMA16(xw[q][ks], fw[ks], cw[q]); ca[q] = MFMA16(xa[q][ks], fa[ks], ca[q]); }
#pragma unroll
                for (int ks = 0; ks < 4; ++ks) cg[q] = MFMA16(xg[q][ks], fg[ks], cg[q]);
                const int jj = nt_ * 16 + fr, tt0 = mt * 16 + fq * 4;
                *(LAS f32x4*)(WPT + jj * RLF + tt0) = cw[q]; *(LAS f32x4*)(APT + jj * RLF + tt0) = ca[q];
                u32x2 gw; gw.x = pk2(cg[q][0], cg[q][1]); gw.y = pk2(cg[q][2], cg[q][3]);
                *(LAS u32x2*)(GT + jj * RL + tt0) = gw; }
        }
        }
        LDS_BAR();
        for (int rep_ = 0; rep_ < RW_REP_EW; ++rep_) {
        RW_LANES
        {
            const int j = lane, tb = wv * 8;
            float wp[8], ap[8], lw[8], asg[8], kmod[8], kkv[8], rr[8], bon[8];
            { const f32x4 x0 = *(const LAS f32x4*)(WPT + j * RLF + tb), x1 = *(const LAS f32x4*)(WPT + j * RLF + tb + 4), y0 = *(const LAS f32x4*)(APT + j * RLF + tb), y1 = *(const LAS f32x4*)(APT + j * RLF + tb + 4);
#pragma unroll
              for (int q = 0; q < 4; ++q) { wp[q] = x0[q] + w0v; wp[q + 4] = x1[q] + w0v; ap[q] = y0[q] + a0v; ap[q + 4] = y1[q] + a0v; } }
#pragma unroll
            for (int tt = 0; tt < 8; ++tt) { const int t = tb + tt;
                const float y = -wp[tt];
                const float sp = softplusf_(y);
                lw[tt] = -__expf(-sp - 0.5f);
                                asg[tt] = sigmoidf_(ap[tt]);
                const float kraw = bf2f(KRB[t * RL + j]); rr[tt] = bf2f(RRB[t * RL + j]);
                const float kkr = kraw * kkw;
                const float ss = wave_sum(kkr * kkr);
                kkv[tt] = kkr * rsqrtf(fmaxf(ss, 1e-24f));
                kmod[tt] = kraw * (1.0f + (asg[tt] - 1.0f) * kaw);
                bon[tt] = wave_sum(rr[tt] * kmod[tt] * rkw); }
            float cum[8]; cum[0] = lw[0];
#pragma unroll
            for (int tt = 1; tt < 8; ++tt) cum[tt] = cum[tt - 1] + lw[tt];
            WTOT[wv * 64 + j] = cum[7];
#pragma unroll
            for (int tt = 0; tt < 8; ++tt) if (lane == tt) BON[tb + tt] = bon[tt];
            LDS_BAR();
            float off = 0.f, tot = 0.f;
#pragma unroll
            for (int w8 = 0; w8 < 8; ++w8) { const float x = WTOT[w8 * 64 + j]; tot += x; if (w8 < wv) off += x; }
            if (wv == 0) GC[j] = __expf(tot);
            unsigned pbh[8], pkh[8], pvt[8];
            const float gcv = __expf(tot); float eprev = __expf(off);
#pragma unroll
            for (int tt = 0; tt < 8; ++tt) { const int t = tb + tt;
                const float c = off + cum[tt];
                const float e1 = __expf(c), ep = eprev, ei = frcp(e1), eh = gcv * ei; eprev = e1;
                const float av = -kkv[tt], bv = kkv[tt] * asg[tt];
                const unsigned short sam = f2bf(av * ep), srm = f2bf(rr[tt] * e1), sbm = f2bf(bv * ei), skm = f2bf(kmod[tt] * ei);
                AM[t * RL + j] = sam; RM[t * RL + j] = srm; BM[t * RL + j] = sbm; KM[t * RL + j] = skm;
                pbh[tt] = f2bf(bv * eh); pkh[tt] = f2bf(kmod[tt] * eh); pvt[tt] = VRB[t * RL + j]; }
            u32x4 w;
            w.x = pbh[0] | (pbh[1] << 16); w.y = pbh[2] | (pbh[3] << 16); w.z = pbh[4] | (pbh[5] << 16); w.w = pbh[6] | (pbh[7] << 16); *(LAS u32x4*)(BH + j * RL + tb) = w;
            w.x = pkh[0] | (pkh[1] << 16); w.y = pkh[2] | (pkh[3] << 16); w.z = pkh[4] | (pkh[5] << 16); w.w = pkh[6] | (pkh[7] << 16); *(LAS u32x4*)(KH + j * RL + tb) = w;
            w.x = pvt[0] | (pvt[1] << 16); w.y = pvt[2] | (pvt[3] << 16); w.z = pvt[4] | (pvt[5] << 16); w.w = pvt[6] | (pvt[7] << 16); *(LAS u32x4*)(VT + j * RL + tb) = w;
        }
        LDS_BAR();
        }
        {
        RW_LANES
#pragma unroll
        for (int q = 0; q < 2; ++q) { const int tile = wv + 8 * q, sbk = tile >> 2, tbk = tile & 3;
            f32x4 pab = (f32x4){0.f, 0.f, 0.f, 0.f};
            if (sbk <= tbk) {
#pragma unroll
                for (int ks = 0; ks < 2; ++ks) pab = MFMA16(lds_frag(BM, sbk * 16, RL, ks * 32, lane), lds_frag(AM, tbk * 16, RL, ks * 32, lane), pab); }
            const int t = tbk * 16 + fr, s0 = sbk * 16 + fq * 4;
            f32x4 lf;
#pragma unroll
            for (int r = 0; r < 4; ++r) lf[r] = (s0 + r < t) ? pab[r] : 0.f;
            *(LAS f32x4*)(LF + t * RLF + s0) = lf; }
        }
        LDS_BAR();
        for (int rep_ = 0; rep_ < RW_REP_AB; ++rep_) {
        RW_LANES
        if (wv == 0) {
            const int d = fq, c = fr;
            float T[16];
#pragma unroll
            for (int i = 0; i < 16; ++i) {
                float a0 = (i == c) ? 1.0f : 0.0f, a1 = 0.f, a2 = 0.f, a3 = 0.f;
#pragma unroll
                for (int jq = 0; jq < (i + 3) / 4; ++jq) { const f32x4 l4 = *(const LAS f32x4*)(LF + (d * 16 + i) * RLF + d * 16 + jq * 4);
                    if (jq * 4 + 0 < i) a0 += l4[0] * T[jq * 4 + 0]; if (jq * 4 + 1 < i) a1 += l4[1] * T[jq * 4 + 1]; if (jq * 4 + 2 < i) a2 += l4[2] * T[jq * 4 + 2]; if (jq * 4 + 3 < i) a3 += l4[3] * T[jq * 4 + 3]; }
                T[i] = (a0 + a1) + (a2 + a3);
                }
#pragma unroll
            for (int i = 0; i < 16; ++i) Wm[(d * 16 + i) * RL + d * 16 + c] = f2bf(T[i]);
            u32x4 w0, w1;
            w0.x = pk2(T[0], T[1]); w0.y = pk2(T[2], T[3]); w0.z = pk2(T[4], T[5]); w0.w = pk2(T[6], T[7]); w1.x = pk2(T[8], T[9]); w1.y = pk2(T[10], T[11]); w1.z = pk2(T[12], T[13]); w1.w = pk2(T[14], T[15]);
            *(LAS u32x4*)(WTR + (d * 16 + c) * RL + d * 16) = w0; *(LAS u32x4*)(WTR + (d * 16 + c) * RL + d * 16 + 8) = w1;
        } else {
            if (wv == 1) {
#pragma unroll
                for (int q = 0; q < 3; ++q) { const int idx = lane + 64 * q, blk = idx >> 5, rem = idx & 31, row = rem >> 1, hf = rem & 1;
                    const int bi = blk < 3 ? 0 : (blk < 5 ? 1 : 2), bj = blk < 3 ? blk + 1 : (blk < 5 ? blk - 1 : 3);
                    *(LAS u32x4*)(Wm + (bi * 16 + row) * RL + bj * 16 + hf * 8) = (u32x4){0u, 0u, 0u, 0u}; }
            }
            for (int tile = wv - 1; tile < 16; tile += 7) { const int sbk = tile >> 2, tbk = tile & 3;
                f32x4 pak = (f32x4){0.f, 0.f, 0.f, 0.f}, prb = pak, prk = pak;
                if (sbk <= tbk) {
#pragma unroll
                    for (int ks = 0; ks < 2; ++ks) { const bf16x8 fb = lds_frag(BM, sbk * 16, RL, ks * 32, lane), fk = lds_frag(KM, sbk * 16, RL, ks * 32, lane), fam = lds_frag(AM, tbk * 16, RL, ks * 32, lane), frm = lds_frag(RM, tbk * 16, RL, ks * 32, lane);
                        pak = MFMA16(fk, fam, pak); prb = MFMA16(fb, frm, prb); prk = MFMA16(fk, frm, prk); } }
                const int t = tbk * 16 + fr, s0 = sbk * 16 + fq * 4;
                u32x2 wak, wrb, wrk; float xak[4], xrb[4], xrk[4];
#pragma unroll
                for (int r = 0; r < 4; ++r) { const int s = s0 + r; xak[r] = (s < t) ? pak[r] : 0.f; xrb[r] = (s <= t) ? prb[r] : 0.f; xrk[r] = (s <= t) ? prk[r] : 0.f; }
                wak.x = pk2(xak[0], xak[1]); wak.y = pk2(xak[2], xak[3]); wrb.x = pk2(xrb[0], xrb[1]); wrb.y = pk2(xrb[2], xrb[3]); wrk.x = pk2(xrk[0], xrk[1]); wrk.y = pk2(xrk[2], xrk[3]);
                *(LAS u32x2*)(LAK + t * RL + s0) = wak; *(LAS u32x2*)(LRB + t * RL + s0) = wrb; *(LAS u32x2*)(LRK + t * RL + s0) = wrk; }
        }
        LDS_BAR();
        }
        for (int rep_ = 0; rep_ < RW_REP_AB; ++rep_) {
        RW_LANES
        if (wv < 3) {
            const int jc = wv;
            LAS bf16_t* zt = ZT + wv * (16 * RL);
            for (int bi = jc + 1; bi < 4; ++bi) {
                f32x4 z = (f32x4){0.f, 0.f, 0.f, 0.f};
                for (int kb = jc; kb < bi; kb += 2) {
                    const int blk = kb + (fq >> 1);
                    const bool on = blk < bi;
                    bf16x8 fa_ = (bf16x8){0, 0, 0, 0, 0, 0, 0, 0}, fb_ = fa_;
                    if (on) { const f32x4 l0 = *(const LAS f32x4*)(LF + (bi * 16 + fr) * RLF + blk * 16 + (fq & 1) * 8), l1 = *(const LAS f32x4*)(LF + (bi * 16 + fr) * RLF + blk * 16 + (fq & 1) * 8 + 4);
                        u32x4 t; t.x = pk2(l0[0], l0[1]); t.y = pk2(l0[2], l0[3]); t.z = pk2(l1[0], l1[1]); t.w = pk2(l1[2], l1[3]); fa_ = __builtin_bit_cast(bf16x8, t);
                        fb_ = *(const LAS bf16x8*)(WTR + (jc * 16 + fr) * RL + blk * 16 + (fq & 1) * 8); }
                    z = MFMA16(fa_, fb_, z);
                }
                { u32x2 w; w.x = pk2(z[0], z[1]); w.y = pk2(z[2], z[3]); *(LAS u32x2*)(zt + fr * RL + fq * 4) = w; }
                asm volatile("s_waitcnt lgkmcnt(0)" ::: "memory");
                bf16x8 ta = (bf16x8){0, 0, 0, 0, 0, 0, 0, 0}, zb = ta;
                if (fq < 2) { ta = *(const LAS bf16x8*)(Wm + (bi * 16 + fr) * RL + bi * 16 + fq * 8); zb = *(const LAS bf16x8*)(zt + fr * RL + fq * 8); }
                f32x4 wn = (f32x4){0.f, 0.f, 0.f, 0.f};
                wn = MFMA16(ta, zb, wn);
#pragma unroll
                for (int r = 0; r < 4; ++r) Wm[(bi * 16 + fq * 4 + r) * RL + jc * 16 + fr] = f2bf(wn[r]);
                { u32x2 w; w.x = pk2(wn[0], wn[1]); w.y = pk2(wn[2], wn[3]); *(LAS u32x2*)(WTR + (jc * 16 + fr) * RL + bi * 16 + fq * 4) = w; }
                asm volatile("s_waitcnt lgkmcnt(0)" ::: "memory");
            }
        } else {
            for (int tile = wv - 3; tile < 16; tile += 5) { const int mt = tile >> 2, nt = tile & 3;
                f32x4 c = (f32x4){0.f, 0.f, 0.f, 0.f};
#pragma unroll
                for (int ks = 0; ks < 2; ++ks) { c = MFMA16(lds_frag(AM, mt * 16, RL, ks * 32, lane), lds_frag(SB, nt * 16, RL, ks * 32, lane), c); c = MFMA16(lds_frag(LAK, mt * 16, RL, ks * 32, lane), lds_frag(VT, nt * 16, RL, ks * 32, lane), c); }
                u32x2 w; w.x = pk2(c[0], c[1]); w.y = pk2(c[2], c[3]); *(LAS u32x2*)(X1T + (nt * 16 + fr) * RL + mt * 16 + fq * 4) = w; }
        }
        LDS_BAR();
        }
        {
        RW_LANES
#pragma unroll
        for (int q = 0; q < 2; ++q) { const int tile = wv + 8 * q, mt = tile >> 2, nt = tile & 3;
            f32x4 c = (f32x4){0.f, 0.f, 0.f, 0.f};
#pragma unroll
            for (int ks = 0; ks < 2; ++ks) c = MFMA16(lds_frag(Wm, mt * 16, RL, ks * 32, lane), lds_frag(X1T, nt * 16, RL, ks * 32, lane), c);
            u32x2 w; w.x = pk2(c[0], c[1]); w.y = pk2(c[2], c[3]); *(LAS u32x2*)(UT + (nt * 16 + fr) * RL + mt * 16 + fq * 4) = w; }
        }
        LDS_BAR();
        {
        RW_LANES
#pragma unroll
        for (int q = 0; q < 2; ++q) { const int tile = wv + 8 * q, mt = tile >> 2, nt = tile & 3;
            f32x4 c = (f32x4){0.f, 0.f, 0.f, 0.f};
#pragma unroll
            for (int ks = 0; ks < 2; ++ks) { c = MFMA16(lds_frag(RM, mt * 16, RL, ks * 32, lane), lds_frag(SB, nt * 16, RL, ks * 32, lane), c);
                c = MFMA16(lds_frag(LRB, mt * 16, RL, ks * 32, lane), lds_frag(UT, nt * 16, RL, ks * 32, lane), c); c = MFMA16(lds_frag(LRK, mt * 16, RL, ks * 32, lane), lds_frag(VT, nt * 16, RL, ks * 32, lane), c); }
            *(LAS f32x4*)(YY + (nt * 16 + fr) * RLF + mt * 16 + fq * 4) = c;
            const f32x4 g4 = *(const LAS f32x4*)(GC + mt * 16 + fq * 4);
            f32x4 s = st[q] * g4;
#pragma unroll
            for (int ks = 0; ks < 2; ++ks) { s = MFMA16(lds_frag(BH, mt * 16, RL, ks * 32, lane), lds_frag(UT, nt * 16, RL, ks * 32, lane), s); s = MFMA16(lds_frag(KH, mt * 16, RL, ks * 32, lane), lds_frag(VT, nt * 16, RL, ks * 32, lane), s); }
            st[q] = s;
            u32x2 w; w.x = pk2(s[0], s[1]); w.y = pk2(s[2], s[3]); *(LAS u32x2*)(SBn + (nt * 16 + fr) * RL + mt * 16 + fq * 4) = w; }
        }
        LDS_BAR();
        for (int rep_ = 0; rep_ < RW_REP_EW; ++rep_) {
        RW_LANES
        {
            const int i = lane, tb = wv * 8;
            const f32x4 y0 = *(const LAS f32x4*)(YY + i * RLF + tb), y1 = *(const LAS f32x4*)(YY + i * RLF + tb + 4);
            const u32x4 v8 = *(const LAS u32x4*)(VT + i * RL + tb), g8 = *(const LAS u32x4*)(GT + i * RL + tb);
            const float yv[8] = {y0[0], y0[1], y0[2], y0[3], y1[0], y1[1], y1[2], y1[3]};
            const float vv[8] = {bflo(v8.x), bfhi(v8.x), bflo(v8.y), bfhi(v8.y), bflo(v8.z), bfhi(v8.z), bflo(v8.w), bfhi(v8.w)};
            const float gv[8] = {bflo(g8.x), bfhi(g8.x), bflo(g8.y), bfhi(g8.y), bflo(g8.z), bfhi(g8.z), bflo(g8.w), bfhi(g8.w)};
#pragma unroll
            for (int tt = 0; tt < 8; ++tt) { const int t = tb + tt;
                const float mean = wave_sum(yv[tt]) * (1.0f / 64.0f);
                const float dlt = yv[tt] - mean;
                const float var = wave_sum(dlt * dlt) * (1.0f / 64.0f);
                float yn = dlt * rsqrtf(var + 64e-5f) * lnw + lnb;
                yn += BON[t] * vv[tt];
                YB[(size_t)(t0 + t) * DM + h * 64 + i] = f2bf(yn * gv[tt]); }
        }
        LDS_BAR();
        }
    }
#undef RW_LANES
}

__device__ __forceinline__ void gla_unit(const Args& a, int unit, LAS unsigned char* lds) {
    const int tid = threadIdx.x, lane = tid & 63, wv = tid >> 6;
    const int b = unit >> 2, h = unit & 3;
    const bf16_t* Z = (const bf16_t*)(a.ws + WS_Z); bf16_t* YA = (bf16_t*)(a.ws + WS_H);
    LAS float* Q = (LAS float*)(lds + 0); LAS float* Kx = (LAS float*)(lds + 16384); LAS float* Ax = (LAS float*)(lds + 32768); LAS float* V = (LAS float*)(lds + 49152);
    LAS float* O = (LAS float*)(lds + 81920); LAS float* GL = (LAS float*)(lds + 114688);
    const int dv = tid >> 1, hf = tid & 1;
    float s[64];
#pragma unroll
    for (int j = 0; j < 64; ++j) s[j] = 0.f;
    for (int nb = 0; nb < 128; ++nb) {
        const int t0 = b * SEQ + nb * 32;
        for (int task = tid; task < 32 * 66; task += 512) {
            const int t = task / 66, g = task - t * 66;
            int zc; LAS float* dst;
            if (g < 16) { zc = ZQ + h * 128 + g * 8; dst = Q + t * 128 + g * 8; }
            else if (g < 32) { zc = ZK + h * 128 + (g - 16) * 8; dst = Kx + t * 128 + (g - 16) * 8; }
            else if (g < 64) { zc = ZV + h * 256 + (g - 32) * 8; dst = V + t * 256 + (g - 32) * 8; }
            else { zc = ZGL + (g - 64) * 8; dst = GL + t * 16 + (g - 64) * 8; }
            const u32x4 cu = *(const u32x4*)(Z + (size_t)(t0 + t) * ZLD + zc);
            dst[0] = bflo(cu.x); dst[1] = bfhi(cu.x); dst[2] = bflo(cu.y); dst[3] = bfhi(cu.y); dst[4] = bflo(cu.z); dst[5] = bfhi(cu.z); dst[6] = bflo(cu.w); dst[7] = bfhi(cu.w);
        }
        LDS_BAR();
        for (int idx = tid; idx < 32 * 128; idx += 512) {
            const int t = idx >> 7, d = idx & 127;
            float acc = a.in[I_GBIAS][h * 128 + d];
#pragma unroll
            for (int m = 0; m < 16; ++m) acc += GL[t * 16 + m] * a.in[I_GUP][m * 512 + h * 128 + d];
            const float ls = fminf(acc, 0.f) - log1pf(__expf(-fabsf(acc)));
            Ax[t * 128 + d] = __expf(ls * (1.0f / 16.0f));
        }
        LDS_BAR();
        for (int t = 0; t < 32; ++t) {
            const float vv = V[t * 256 + dv];
            float o = 0.f;
#pragma unroll
            for (int q = 0; q < 16; ++q) {
                const f32x4 a4 = *(const LAS f32x4*)(Ax + t * 128 + hf * 64 + q * 4), k4 = *(const LAS f32x4*)(Kx + t * 128 + hf * 64 + q * 4), q4 = *(const LAS f32x4*)(Q + t * 128 + hf * 64 + q * 4);
#pragma unroll
                for (int r = 0; r < 4; ++r) { s[q * 4 + r] = s[q * 4 + r] * a4[r] + k4[r] * vv; o += q4[r] * s[q * 4 + r]; }
            }
            o += __shfl_xor(o, 1);
            if (hf == 0) O[t * 256 + dv] = o * 0.08838834764831845f;
        }
        LDS_BAR();
#pragma unroll
        for (int tt = 0; tt < 4; ++tt) {
            const int t = wv * 4 + tt;
            const f32x4 o4 = *(const LAS f32x4*)(O + t * 256 + lane * 4);
            const float ss = wave_sum(o4[0] * o4[0] + o4[1] * o4[1] + o4[2] * o4[2] + o4[3] * o4[3]);
            const float rs = rsqrtf(ss * (1.0f / 256.0f) + 1e-5f);
            const u32x2 og = *(const u32x2*)(Z + (size_t)(t0 + t) * ZLD + ZOG + h * 256 + lane * 4);
            const f32x4 ng = *(const f32x4*)(a.in[I_GNG] + lane * 4);
            const float g0 = bflo(og.x), g1 = bfhi(og.x), g2 = bflo(og.y), g3 = bfhi(og.y);
            u32x2 w;
            w.x = pk2(o4[0] * rs * ng[0] * (g0 * sigmoidf_(g0)), o4[1] * rs * ng[1] * (g1 * sigmoidf_(g1)));
            w.y = pk2(o4[2] * rs * ng[2] * (g2 * sigmoidf_(g2)), o4[3] * rs * ng[3] * (g3 * sigmoidf_(g3)));
            *(u32x2*)(YA + (size_t)(t0 + t) * DM + h * 256 + lane * 4) = w;
        }
        LDS_BAR();
    }
}
constexpr int GP = 136;
constexpr int GO_QS = 0, GO_KS = 17408, GO_QI = 34816, GO_KE = 52224  , GO_VT = 70656  , GO_P = 107520  , GO_GLT = GO_P  ;
constexpr int GO_LAT = 116736  , GO_O = GO_LAT  , GO_TOT = 151552  , GO_LA32 = 153600, GO_GD = 154112, GO_SS = 154624  , GO_NG = 156672  ;
static_assert(GO_NG + 1024 <= MISC_OFF, "gla LDS map");
__device__ __forceinline__ void gla_fast_unit(const Args& a, int unit, LAS unsigned char* lds) {
    const int tid0 = threadIdx.x, lane0 = tid0 & 63, wv = __builtin_amdgcn_readfirstlane(tid0 >> 6);
    const int b = unit >> 2, h = unit & 3;
#define GL_LANES int lane = lane0; asm volatile("" : "+v"(lane)); const int fr = lane & 15, fq = lane >> 4, tid = wv * 64 + lane; (void)fr; (void)fq; (void)tid;
    const bf16_t* Z = (const bf16_t*)(a.ws + WS_Z); bf16_t* YA = (bf16_t*)(a.ws + WS_H);
    LAS bf16_t* QS = (LAS bf16_t*)(lds + GO_QS); LAS bf16_t* KS = (LAS bf16_t*)(lds + GO_KS); LAS bf16_t* QI = (LAS bf16_t*)(lds + GO_QI); LAS bf16_t* KE = (LAS bf16_t*)(lds + GO_KE);
    LAS bf16_t* VT = (LAS bf16_t*)(lds + GO_VT); LAS bf16_t* P = (LAS bf16_t*)(lds + GO_P); LAS bf16_t* GLT = (LAS bf16_t*)(lds + GO_GLT); LAS float* LAT = (LAS float*)(lds + GO_LAT);
    LAS bf16_t* O = (LAS bf16_t*)(lds + GO_O); LAS float* TOT = (LAS float*)(lds + GO_TOT); LAS float* LA32 = (LAS float*)(lds + GO_LA32); LAS float* GD = (LAS float*)(lds + GO_GD); LAS float* SS = (LAS float*)(lds + GO_SS);
    bf16x8 fgu[4]; float gbias[4];
    u32x4 pv_[4], pqk_[4], pog_[4], pgl_;
    f32x4 S[8][2];
    {
    GL_LANES
#pragma unroll
    for (int q = 0; q < 4; ++q) { const int d = ((wv >> 2) + 2 * q) * 16 + fr; unsigned pw[4];
#pragma unroll
        for (int r = 0; r < 4; ++r) { const int m = fq * 8 + r * 2; pw[r] = (fq < 2) ? pk2(a.in[I_GUP][m * 512 + h * 128 + d], a.in[I_GUP][(m + 1) * 512 + h * 128 + d]) : 0u; }
        u32x4 t; t.x = pw[0]; t.y = pw[1]; t.z = pw[2]; t.w = pw[3]; fgu[q] = __builtin_bit_cast(bf16x8, t);
        gbias[q] = a.in[I_GBIAS][h * 128 + d]; }
#pragma unroll
    for (int dt = 0; dt < 8; ++dt) { S[dt][0] = (f32x4){0.f, 0.f, 0.f, 0.f}; S[dt][1] = S[dt][0]; }
    { const int tb0 = b * SEQ;
#pragma unroll
      for (int it = 0; it < 4; ++it) { const int task = tid + it * 512, g = wv + 8 * it;
          pv_[it] = *(const u32x4*)(Z + (size_t)(tb0 + lane) * ZLD + ZV + h * 256 + g * 8);
          const int arr = task >> 10, tq = (task >> 4) & 63, gq = task & 15;
          pqk_[it] = *(const u32x4*)(Z + (size_t)(tb0 + tq) * ZLD + (arr ? ZK : ZQ) + h * 128 + gq * 8); }
      pgl_ = (u32x4){0u, 0u, 0u, 0u};
      if (tid < 256) ((LAS float*)(lds + GO_NG))[tid] = a.in[I_GNG][tid];
      if (tid < 128) pgl_ = *(const u32x4*)(Z + (size_t)(tb0 + (tid >> 1)) * ZLD + ZGL + (tid & 1) * 8);
#pragma unroll
      for (int q = 0; q < 4; ++q) pog_[q] = *(const u32x4*)(Z + (size_t)(tb0 + (tid >> 3)) * ZLD + ZOG + h * 256 + (tid & 7) * 32 + q * 8); }
    }
    for (int n = 0; n < 64; ++n) {
        const int t0 = b * SEQ + n * 64;
        {
        GL_LANES
#pragma unroll
        for (int it = 0; it < 4; ++it) { const int g = wv + 8 * it;
            const u32x4 cu = pv_[it];
            LAS bf16_t* dst = VT + (g * 8) * RL + lane;
            dst[0] = (bf16_t)(cu.x & 0xffffu); dst[RL] = (bf16_t)(cu.x >> 16); dst[2 * RL] = (bf16_t)(cu.y & 0xffffu); dst[3 * RL] = (bf16_t)(cu.y >> 16);
            dst[4 * RL] = (bf16_t)(cu.z & 0xffffu); dst[5 * RL] = (bf16_t)(cu.z >> 16); dst[6 * RL] = (bf16_t)(cu.w & 0xffffu); dst[7 * RL] = (bf16_t)(cu.w >> 16);
            const int task = tid + it * 512, arr = task >> 10, tq = (task >> 4) & 63, gq = task & 15;
            *(LAS u32x4*)((arr ? KS : QS) + tq * GP + gq * 8) = pqk_[it]; }
        if (tid < 128) { const int t = tid >> 1, g = tid & 1; *(LAS u32x4*)(GLT + t * 40 + g * 8) = pgl_; }
        else if (tid < 256) { const int q = tid - 128, t = q >> 1, g = q & 1; *(LAS u32x4*)(GLT + t * 40 + 16 + g * 8) = (u32x4){0u, 0u, 0u, 0u}; }
        if (n + 1 < 64) {
#pragma unroll
            for (int it = 0; it < 4; ++it) { const int g = wv + 8 * it;
                pv_[it] = *(const u32x4*)(Z + (size_t)(t0 + 64 + lane) * ZLD + ZV + h * 256 + g * 8);
                const int task = tid + it * 512, arr = task >> 10, tq = (task >> 4) & 63, gq = task & 15;
                pqk_[it] = *(const u32x4*)(Z + (size_t)(t0 + 64 + tq) * ZLD + (arr ? ZK : ZQ) + h * 128 + gq * 8); }
            if (tid < 128) pgl_ = *(const u32x4*)(Z + (size_t)(t0 + 64 + (tid >> 1)) * ZLD + ZGL + (tid & 1) * 8);
        }
        }
        LDS_BAR();
        {
        GL_LANES
        const int mt = wv & 3;
        const bf16x8 fa_ = *(const LAS bf16x8*)(GLT + (mt * 16 + fr) * 40 + fq * 8);
#pragma unroll
        for (int q = 0; q < 4; ++q) { const int nt = (wv >> 2) + 2 * q;
            f32x4 c = (f32x4){0.f, 0.f, 0.f, 0.f};
            c = MFMA16(fa_, fgu[q], c);
            f32x4 la;
#pragma unroll
            for (int r = 0; r < 4; ++r) { const float x = c[r] + gbias[q]; la[r] = -softplusf_(-x) * (1.0f / 16.0f); }
            *(LAS f32x4*)(LAT + (nt * 16 + fr) * RLF + mt * 16 + fq * 4) = la; }
        }
        LDS_BAR();
        {
        GL_LANES
        const int d = tid & 127, tg = tid >> 7, tb = tg * 16;
        float p[16];
#pragma unroll
        for (int q = 0; q < 4; ++q) { const f32x4 x = *(const LAS f32x4*)(LAT + d * RLF + tb + q * 4); p[q * 4] = x[0]; p[q * 4 + 1] = x[1]; p[q * 4 + 2] = x[2]; p[q * 4 + 3] = x[3]; }
#pragma unroll
        for (int i = 1; i < 16; ++i) p[i] += p[i - 1];
        TOT[tg * 128 + d] = p[15];
        if (tg == 2) LA32[d] = p[0];
        LDS_BAR();
        const float T0 = TOT[d], T1 = TOT[128 + d], T2 = TOT[256 + d], T3 = TOT[384 + d];
        const float off = (tg > 0 ? T0 : 0.f) + (tg > 1 ? T1 : 0.f) + (tg > 2 ? T2 : 0.f);
        const float bref = T0 + T1 + LA32[d], bend = (T0 + T1) + (T2 + T3);
        if (tg == 0) GD[d] = __expf(bend);
        const float eref = __expf(bref), eend = __expf(bend - bref);
        unsigned ke[16];
#pragma unroll
        for (int i = 0; i < 16; ++i) { const int t = tb + i;
            const float bb = off + p[i];
            const float qv = bf2f(QS[t * GP + d]) * 0.08838834764831845f, kv = bf2f(KS[t * GP + d]);
            const float eq = __expf(bb - bref), ek = frcp(eq); QS[t * GP + d] = f2bf(qv * eq); KS[t * GP + d] = f2bf(kv * ek); QI[t * GP + d] = f2bf(qv * (eq * eref));
            ke[i] = f2bf(kv * (ek * eend)); }
        u32x4 w;
        w.x = ke[0] | (ke[1] << 16); w.y = ke[2] | (ke[3] << 16); w.z = ke[4] | (ke[5] << 16); w.w = ke[6] | (ke[7] << 16); *(LAS u32x4*)(KE + d * RL + tb) = w;
        w.x = ke[8] | (ke[9] << 16); w.y = ke[10] | (ke[11] << 16); w.z = ke[12] | (ke[13] << 16); w.w = ke[14] | (ke[15] << 16); *(LAS u32x4*)(KE + d * RL + tb + 8) = w;
        }
        LDS_BAR();
        {
        GL_LANES
#pragma unroll
        for (int q = 0; q < 2; ++q) { const int tile = wv + 8 * q, sbk = tile >> 2, tbk = tile & 3;
            f32x4 c = (f32x4){0.f, 0.f, 0.f, 0.f};
            if (sbk <= tbk) {
#pragma unroll
                for (int ks = 0; ks < 4; ++ks) c = MFMA16(lds_frag(KS, sbk * 16, GP, ks * 32, lane), lds_frag(QS, tbk * 16, GP, ks * 32, lane), c); }
            const int t = tbk * 16 + fr, s0 = sbk * 16 + fq * 4;
            float x[4];
#pragma unroll
            for (int r = 0; r < 4; ++r) x[r] = (s0 + r <= t) ? c[r] : 0.f;
            u32x2 w; w.x = pk2(x[0], x[1]); w.y = pk2(x[2], x[3]); *(LAS u32x2*)(P + t * RL + s0) = w; }
        }
        LDS_BAR();
        {
        GL_LANES
        bf16x8 sb[4][2];
#pragma unroll
        for (int ks = 0; ks < 4; ++ks)
#pragma unroll
            for (int v2 = 0; v2 < 2; ++v2) { const f32x4 lo = S[2 * ks][v2], hi = S[2 * ks + 1][v2];
                u32x4 t; t.x = pk2(lo[0], lo[1]); t.y = pk2(lo[2], lo[3]); t.z = pk2(hi[0], hi[1]); t.w = pk2(hi[2], hi[3]); sb[ks][v2] = __builtin_bit_cast(bf16x8, t); }
        const int v0 = wv * 32;
#pragma unroll
        for (int mt = 0; mt < 4; ++mt) {
            f32x4 o0 = (f32x4){0.f, 0.f, 0.f, 0.f}, o1 = o0;
#pragma unroll
            for (int ks = 0; ks < 2; ++ks) { const bf16x8 fp = lds_frag(P, mt * 16, RL, ks * 32, lane);
                o0 = MFMA16(fp, lds_frag(VT, v0, RL, ks * 32, lane), o0); o1 = MFMA16(fp, lds_frag(VT, v0 + 16, RL, ks * 32, lane), o1); }
#pragma unroll
            for (int ks = 0; ks < 4; ++ks) {
                const u32x2 qa = *(const LAS u32x2*)(QI + (mt * 16 + fr) * GP + ks * 32 + fq * 4), qb = *(const LAS u32x2*)(QI + (mt * 16 + fr) * GP + ks * 32 + 16 + fq * 4);
                u32x4 t; t.x = qa.x; t.y = qa.y; t.z = qb.x; t.w = qb.y; const bf16x8 fqi = __builtin_bit_cast(bf16x8, t);
                o0 = MFMA16(fqi, sb[ks][0], o0); o1 = MFMA16(fqi, sb[ks][1], o1); }
#pragma unroll
            for (int r = 0; r < 4; ++r) { const int t = mt * 16 + fq * 4 + r;
                O[t * 264 + v0 + fr] = f2bf(o0[r]); O[t * 264 + v0 + 16 + fr] = f2bf(o1[r]);
                float x = o0[r] * o0[r] + o1[r] * o1[r];
                x = rowsum16(x);
                if (fr == 0) SS[wv * 64 + t] = x; }
        }
        bf16x8 fv[2][2];
#pragma unroll
        for (int ks = 0; ks < 2; ++ks) { fv[ks][0] = lds_frag(VT, v0, RL, ks * 32, lane); fv[ks][1] = lds_frag(VT, v0 + 16, RL, ks * 32, lane); }
#pragma unroll
        for (int dt = 0; dt < 8; ++dt) { const f32x4 g4 = *(const LAS f32x4*)(GD + dt * 16 + fq * 4);
            f32x4 s0 = S[dt][0] * g4, s1 = S[dt][1] * g4;
#pragma unroll
            for (int ks = 0; ks < 2; ++ks) { const bf16x8 fk = lds_frag(KE, dt * 16, RL, ks * 32, lane);
                s0 = MFMA16(fk, fv[ks][0], s0); s1 = MFMA16(fk, fv[ks][1], s1); }
            S[dt][0] = s0; S[dt][1] = s1; }
        }
        LDS_BAR();
        {
        GL_LANES
        const int t = tid >> 3, c0 = (tid & 7) * 32;
        float ss = 0.f;
#pragma unroll
        for (int w8 = 0; w8 < 8; ++w8) ss += SS[w8 * 64 + t];
        const float rs = rsqrtf(ss * (1.0f / 256.0f) + 1e-5f);
        const bf16_t* ogp = Z + (size_t)(t0 + t) * ZLD + ZOG + h * 256 + c0; bf16_t* yp = YA + (size_t)(t0 + t) * DM + h * 256 + c0;
#pragma unroll
        for (int q = 0; q < 4; ++q) { const u32x4 o8 = *(const LAS u32x4*)(O + t * 264 + c0 + q * 8); const u32x4 g8 = pog_[q];
            const f32x4 n0 = *(const LAS f32x4*)((LAS float*)(lds + GO_NG) + c0 + q * 8), n1 = *(const LAS f32x4*)((LAS float*)(lds + GO_NG) + c0 + q * 8 + 4);
            const float ov[8] = {bflo(o8.x), bfhi(o8.x), bflo(o8.y), bfhi(o8.y), bflo(o8.z), bfhi(o8.z), bflo(o8.w), bfhi(o8.w)};
            const float gv[8] = {bflo(g8.x), bfhi(g8.x), bflo(g8.y), bfhi(g8.y), bflo(g8.z), bfhi(g8.z), bflo(g8.w), bfhi(g8.w)};
            const float nv[8] = {n0[0], n0[1], n0[2], n0[3], n1[0], n1[1], n1[2], n1[3]};
            float y[8];
#pragma unroll
            for (int e = 0; e < 8; ++e) y[e] = ov[e] * rs * nv[e] * (gv[e] * sigmoidf_(gv[e]));
            u32x4 w; w.x = pk2(y[0], y[1]); w.y = pk2(y[2], y[3]); w.z = pk2(y[4], y[5]); w.w = pk2(y[6], y[7]);
            *(u32x4*)(yp + q * 8) = w; }
        if (n + 1 < 64) {
#pragma unroll
            for (int q = 0; q < 4; ++q) pog_[q] = *(const u32x4*)(ogp + (size_t)64 * ZLD + q * 8); }
        }
        LDS_BAR();
    }
#undef GL_LANES
}

#ifndef SCAN_PROBE
#define SCAN_PROBE 0
#endif
template <int hb> __device__ __forceinline__ void scan_phase(const Args& a, LAS unsigned char* lds) {
    if (blockIdx.x >= 160) {
        if constexpr (hb == 0) {
            prologue_phase(a, lds, (int)blockIdx.x - 160, (int)gridDim.x - 160, PRO_T3, PRO_T5);
            rmsnorm_phase(a.in[I_X] + (size_t)TH * DM, a.in[I_NMG], (bf16_t*)(a.out + (size_t)TH * DM), (int)blockIdx.x - 160, (int)gridDim.x - 160);
        }
        return;
    }
    for (int u = blockIdx.x; u < 160; u += gridDim.x) {
        if (u < 128) {
            rwkv_fast_unit(a, u, lds);
            if constexpr (SCAN_PROBE == 1) rwkv_fast_unit(a, u, lds);
        } else {
            gla_fast_unit(a, u - 128, lds);
            if constexpr (SCAN_PROBE == 2) gla_fast_unit(a, u - 128, lds);
        }
    }
}

__device__ __forceinline__ void router_phase(const Args& a, int hb, LAS unsigned char* lds) {
    const int tid = threadIdx.x, lane = tid & 63, wv = tid >> 6;
    LAS float* wt = (LAS float*)lds;
    LAS unsigned* hist = (LAS unsigned*)(lds + 131072);
    const float* rw = a.in[I_RW];
    for (int idx = tid; idx < 32 * 1024; idx += 512) { const int k = idx >> 5, e = idx & 31; wt[e * 1024 + k] = rw[idx]; }
    if (tid < 32) hist[tid] = 0u;
    __syncthreads();
    const float* x1 = a.out + (size_t)hb * TH * DM; bf16_t* H2 = (bf16_t*)(a.ws + WS_H2);
    int* tope = (int*)(a.ws + WS_TOPE); float* topg = (float*)(a.ws + WS_TOPG);
    const float* gain = a.in[I_NFG];
    const int gw = blockIdx.x * 8 + wv, nw = gridDim.x * 8;
    for (int row = gw; row < TH; row += nw) {
        const f32x4* xr = (const f32x4*)(x1 + (size_t)row * DM);
        f32x4 v[4]; float ss = 0.f;
#pragma unroll
        for (int i = 0; i < 4; ++i) { v[i] = xr[i * 64 + lane]; ss += v[i][0] * v[i][0] + v[i][1] * v[i][1] + v[i][2] * v[i][2] + v[i][3] * v[i][3]; }
        ss = wave_sum(ss);
        const float rs = rsqrtf(ss * (1.0f / 1024.0f) + 1e-6f);
#pragma unroll
        for (int i = 0; i < 4; ++i) { const f32x4 g = ((const f32x4*)gain)[i * 64 + lane]; v[i] = v[i] * rs * g;
            u32x2 w; w.x = pk2(v[i][0], v[i][1]); w.y = pk2(v[i][2], v[i][3]);
            *(u32x2*)(H2 + (size_t)row * DM + (i * 64 + lane) * 4) = w; }
        float p[32];
#pragma unroll
        for (int e = 0; e < 32; ++e) { float acc = 0.f;
#pragma unroll
            for (int i = 0; i < 4; ++i) { const f32x4 w4 = *(const LAS f32x4*)(wt + e * 1024 + (i * 64 + lane) * 4); acc += v[i][0] * w4[0] + v[i][1] * w4[1] + v[i][2] * w4[2] + v[i][3] * w4[3]; }
            p[e] = acc; }
#pragma unroll
        for (int i = 0; i < 16; ++i) { const bool up = (lane & 32) != 0; const float send = up ? p[i] : p[i + 16], keep = up ? p[i + 16] : p[i]; p[i] = keep + __shfl_xor(send, 32); }
#pragma unroll
        for (int i = 0; i < 8; ++i) { const bool up = (lane & 16) != 0; const float send = up ? p[i] : p[i + 8], keep = up ? p[i + 8] : p[i]; p[i] = keep + __shfl_xor(send, 16); }
#pragma unroll
        for (int i = 0; i < 4; ++i) { const bool up = (lane & 8) != 0; const float send = up ? p[i] : p[i + 4], keep = up ? p[i + 4] : p[i]; p[i] = keep + __shfl_xor(send, 8); }
#pragma unroll
        for (int i = 0; i < 2; ++i) { const bool up = (lane & 4) != 0; const float send = up ? p[i] : p[i + 2], keep = up ? p[i + 2] : p[i]; p[i] = keep + __shfl_xor(send, 4); }
        { const bool up = (lane & 2) != 0; const float send = up ? p[0] : p[1], keep = up ? p[1] : p[0]; p[0] = keep + __shfl_xor(send, 2); }
        p[0] += __shfl_xor(p[0], 1);
        const int e = lane >> 1;
        float val = p[0] + a.in[I_RB][e];
        float tv[4]; int te[4];
#pragma unroll
        for (int k = 0; k < 4; ++k) {
            const float m = wave_max(val);
            const int cand = (val == m) ? e : 64;
            const int em = wave_min_i(cand);
            tv[k] = m; te[k] = em;
            if (e == em) val = -3.0e38f;
        }
        const float e1 = __expf(tv[1] - tv[0]), e2 = __expf(tv[2] - tv[0]), e3 = __expf(tv[3] - tv[0]);
        const float inv = 1.0f / (1.0f + e1 + e2 + e3);
        if (lane == 0) {
            *(int4*)(tope + (size_t)row * 4) = make_int4(te[0], te[1], te[2], te[3]);
            *(float4*)(topg + (size_t)row * 4) = make_float4(inv, e1 * inv, e2 * inv, e3 * inv);
#pragma unroll
            for (int k = 0; k < 4; ++k) __hip_atomic_fetch_add(hist + te[k], 1u, __ATOMIC_RELAXED, __HIP_MEMORY_SCOPE_WORKGROUP);
        }
    }
    __syncthreads();
    if (tid < 32) { unsigned* cnt = (unsigned*)(a.ws + WS_CTL) + CW_CNT + hb * 64; __hip_atomic_fetch_add(cnt + tid, hist[tid], __ATOMIC_RELAXED, __HIP_MEMORY_SCOPE_AGENT); }
    __syncthreads();
}

__device__ __forceinline__ void assign_phase(const Args& a, int hb, LAS unsigned char* lds) {
    const int tid = threadIdx.x;
    LAS unsigned* sm = (LAS unsigned*)lds;
    unsigned* ctl = (unsigned*)(a.ws + WS_CTL);
    if (tid < 64) {
        const int e = tid & 31;
        const unsigned c = __hip_atomic_load(ctl + CW_CNT + hb * 64 + e, __ATOMIC_RELAXED, __HIP_MEMORY_SCOPE_AGENT);
        const unsigned pc = (c + 255u) & ~255u;
        unsigned incl = pc;
#pragma unroll
        for (int o = 1; o < 32; o <<= 1) { const unsigned up = __shfl_up(incl, o, 32); if (e >= o) incl += up; }
        if (tid < 32) { sm[32 + e] = incl - pc; sm[96 + e] = c; sm[128 + e] = pc; }
        if (tid == 31 && blockIdx.x == 0) ctl[CW_NBLK + hb] = incl >> 8;
    }
    __syncthreads();
    const int* tope = (const int*)(a.ws + WS_TOPE); const float* topg = (const float*)(a.ws + WS_TOPG);
    int* rtok = (int*)(a.ws + WS_RTOK); float* rgate = (float*)(a.ws + WS_RGATE); int* dest = (int*)(a.ws + WS_DEST); int* blke = (int*)(a.ws + WS_BLKE);
    for (int base_t = blockIdx.x * 128; base_t < TH; base_t += gridDim.x * 128) {
        if (tid < 32) sm[tid] = 0u;
        __syncthreads();
        const int t = base_t + (tid >> 2), k = tid & 3;
        const int e = tope[(size_t)t * 4 + k];
        const unsigned lr = __hip_atomic_fetch_add(sm + e, 1u, __ATOMIC_RELAXED, __HIP_MEMORY_SCOPE_WORKGROUP);
        __syncthreads();
        if (tid < 32) sm[64 + tid] = __hip_atomic_fetch_add(ctl + CW_CUR + hb * 64 + tid, sm[tid], __ATOMIC_RELAXED, __HIP_MEMORY_SCOPE_AGENT);
        __syncthreads();
        const int d = (int)(sm[32 + e] + sm[64 + e] + lr);
        rtok[d] = t; rgate[d] = topg[(size_t)t * 4 + k]; dest[(size_t)t * 4 + k] = d;
        __syncthreads();
    }
    for (int e = blockIdx.x; e < 32; e += gridDim.x) {
        const int ps = (int)sm[32 + e], c = (int)sm[96 + e], pc = (int)sm[128 + e];
        for (int r = ps + c + tid; r < ps + pc; r += 512) { rtok[r] = 0; rgate[r] = 0.f; }
        for (int blk = (ps >> 8) + tid; blk < ((ps + pc) >> 8); blk += 512) blke[blk] = e;
    }
}

__device__ __forceinline__ void combine_phase(const Args& a, int hb) {
    const int lane = threadIdx.x & 63, gw = blockIdx.x * 8 + (threadIdx.x >> 6), nw = gridDim.x * 8;
    float* x1 = a.out + (size_t)hb * TH * DM; const bf16_t* OUTS = (const bf16_t*)(a.ws + WS_OUTS); const int* dest = (const int*)(a.ws + WS_DEST);
    const float* gain = a.in[I_NFIN];
    for (int row = gw; row < TH; row += nw) {
        f32x4* xr = (f32x4*)(x1 + (size_t)row * DM);
        const int4 d4 = *(const int4*)(dest + (size_t)row * 4);
        const int dd[4] = {d4.x, d4.y, d4.z, d4.w};
        f32x4 v[4];
#pragma unroll
        for (int i = 0; i < 4; ++i) v[i] = xr[i * 64 + lane];
#pragma unroll
        for (int k = 0; k < 4; ++k) { const bf16_t* orow = OUTS + (size_t)dd[k] * DM;
#pragma unroll
            for (int i = 0; i < 4; ++i) { const u32x2 w = *(const u32x2*)(orow + (i * 64 + lane) * 4); v[i][0] += bflo(w.x); v[i][1] += bfhi(w.x); v[i][2] += bflo(w.y); v[i][3] += bfhi(w.y); } }
        float ss = 0.f;
#pragma unroll
        for (int i = 0; i < 4; ++i) ss += v[i][0] * v[i][0] + v[i][1] * v[i][1] + v[i][2] * v[i][2] + v[i][3] * v[i][3];
        ss = wave_sum(ss);
        const float rs = rsqrtf(ss * (1.0f / 1024.0f) + 1e-6f);
#pragma unroll
        for (int i = 0; i < 4; ++i) { const f32x4 g = ((const f32x4*)gain)[i * 64 + lane]; xr[i * 64 + lane] = v[i] * rs * g; }
    }
}

#define PH(k) (lo <= (k) && (k) < hi)
#define SEAM(k) do { if (PH(k) && PH((k) + 1)) xcd_barrier(bar); } while (0)
template <int hb> __device__ __forceinline__ void half_program(const Args& a, LAS unsigned char* lds, const XcdBarrier& bar, const int lo, const int hi) {
    unsigned char* ws = a.ws;
        const int pb = 1 + hb * 10;
        const float* xh = a.in[I_X] + (size_t)hb * TH * DM;
        float* outh = a.out + (size_t)hb * TH * DM;
        if (PH(pb + 1)) { RUNPH(2, {
            pg8::Gemm g{hb == 0 ? (const bf16_t*)(ws + WS_H) : (const bf16_t*)(a.out + (size_t)TH * DM), (const bf16_t*)(ws + WS_WIN), 1024}; pg8::StaticOrder S; S.init(TH, ZLD, gridDim.x, blockIdx.x);
            pg8::EpiZ E{(bf16_t*)(ws + WS_Z), ZLD};
            pg8::gemm_phase(lds, g, S, E);
        }); } SEAM(pb + 1);
        if (PH(pb + 2)) { RUNPH(3, { scan_phase<hb>(a, lds); }); } SEAM(pb + 2);
        if (PH(pb + 3)) { RUNPH(4, {
            pg8::StaticOrder S; S.init(TH, 1024, gridDim.x, blockIdx.x);
            { pg8::Gemm g{(const bf16_t*)(ws + WS_H), (const bf16_t*)(ws + WS_WA), 1024}; pg8::EpiGate<true> E{(const bf16_t*)(ws + WS_Z), ZGA, (bf16_t*)(ws + WS_MG)}; pg8::gemm_phase(lds, g, S, E); }
            { pg8::Gemm g{(const bf16_t*)(ws + WS_YB), (const bf16_t*)(ws + WS_WB), 1024}; pg8::EpiGate<false> E{(const bf16_t*)(ws + WS_Z), ZGB, (bf16_t*)(ws + WS_MG)}; pg8::gemm_phase(lds, g, S, E); }
        }); } SEAM(pb + 3);
        if (PH(pb + 4)) { RUNPH(5, {
            pg8::Gemm g{(const bf16_t*)(ws + WS_MG), (const bf16_t*)(ws + WS_WO), 1024}; pg8::StaticOrder S; S.init(TH, 1024, gridDim.x, blockIdx.x);
            pg8::EpiRes E{xh, outh};
            pg8::gemm_phase(lds, g, S, E);
        }); } SEAM(pb + 4);
        if (PH(pb + 5)) { RUNPH(6, { router_phase(a, hb, lds); }); } SEAM(pb + 5);
        if (PH(pb + 6)) { RUNPH(7, { assign_phase(a, hb, lds); }); } SEAM(pb + 6);
        if (PH(pb + 7)) { RUNPH(8, {
            const int nblk = (int)((const unsigned*)(ws + WS_CTL))[CW_NBLK + hb];
            pg8::Gemm g{(const bf16_t*)(ws + WS_H2), (const bf16_t*)(ws + WS_W1), 1024};
            pg8::MoeOrder<true> S{nblk * 8, (int)gridDim.x, (int)blockIdx.x, 3, 8, (const int*)(ws + WS_BLKE), (const int*)(ws + WS_RTOK)};
            pg8::EpiSwiglu E{a.in[I_EB1], (bf16_t*)(ws + WS_ACT)};
            pg8::gemm_phase(lds, g, S, E);
        }); } SEAM(pb + 7);
        if (PH(pb + 8)) { RUNPH(9, {
            const int nblk = (int)((const unsigned*)(ws + WS_CTL))[CW_NBLK + hb];
            pg8::Gemm g{(const bf16_t*)(ws + WS_ACT), (const bf16_t*)(ws + WS_W2), 1024};
            pg8::MoeOrder<false> S{nblk * 4, (int)gridDim.x, (int)blockIdx.x, 2, 4, (const int*)(ws + WS_BLKE), nullptr};
            pg8::EpiMoe2 E{a.in[I_EB2], (const float*)(ws + WS_RGATE), (bf16_t*)(ws + WS_OUTS)};
            pg8::gemm_phase(lds, g, S, E);
        }); } SEAM(pb + 8);
        if (PH(pb + 9)) { RUNPH(10, { combine_phase(a, hb); }); } SEAM(pb + 9);
}
#undef PH
#undef SEAM
constexpr int NPHASE = 21;
__global__ void __launch_bounds__(512, 2) mega(Args a) {
    extern __shared__ __attribute__((aligned(16))) unsigned char lds_raw[];
    LAS unsigned char* lds = (LAS unsigned char*)lds_raw;
    unsigned char* ws = a.ws;
    const int lo = a.ph_lo, hi = a.ph_hi;
    XcdBarrier bar; bar.bar = (unsigned*)(ws + WS_CTL); bar.x = 0; bar.st = nullptr;
    if (hi - lo > 1) {
        volatile LAS unsigned* misc = (volatile LAS unsigned*)(lds + MISC_OFF);
        if (threadIdx.x < 4) misc[threadIdx.x] = 0u;
        __syncthreads();
        bar = xcd_barrier_post((unsigned*)(ws + WS_CTL), misc);
    }
#define PH(k) (lo <= (k) && (k) < hi)
#define SEAM(k) do { if (PH(k) && PH((k) + 1)) xcd_barrier(bar); } while (0)
    if (PH(0)) { RUNPH(0, { prologue_phase(a, lds, (int)blockIdx.x, (int)gridDim.x, 0, PRO_T3); rmsnorm_phase(a.in[I_X], a.in[I_NMG], (bf16_t*)(ws + WS_H), (int)blockIdx.x, (int)gridDim.x); }); } SEAM(0);
    half_program<0>(a, lds, bar, lo, hi);
    half_program<1>(a, lds, bar, lo, hi);
#undef PH
#undef SEAM
}

extern "C" void kernel_launch(void* const* d_in, const int* in_sizes, int n_in, void* d_out, int out_size, void* d_ws, size_t ws_size, hipStream_t stream) {
    static int grid = 0;
    if (grid == 0) {
        if (n_in != 28 || out_size != 65536 * 1024 || ws_size < WS_END) { fprintf(stderr, "kernel_launch: unexpected shapes (n_in %d out %d ws %zu need %zu)\n", n_in, out_size, ws_size, (size_t)WS_END); grid = -1; return; }
        int dev = 0, cus = 0;
        if (hipGetDevice(&dev) != hipSuccess || hipDeviceGetAttribute(&cus, hipDeviceAttributeMultiprocessorCount, dev) != hipSuccess) { grid = -1; return; }
        if (hipFuncSetAttribute((const void*)mega, hipFuncAttributeMaxDynamicSharedMemorySize, LDS_BYTES) != hipSuccess) { fprintf(stderr, "kernel_launch: hipFuncSetAttribute failed\n"); grid = -1; return; }
        int per_cu = 0;
        if (hipOccupancyMaxActiveBlocksPerMultiprocessor(&per_cu, (const void*)mega, 512, LDS_BYTES) != hipSuccess || per_cu < 1) fprintf(stderr, "kernel_launch: occupancy query says %d\n", per_cu);
        (void)hipGetLastError();
        grid = cus > 256 ? 256 : cus;
    }
    if (grid < 0) return;
    (void)hipMemsetAsync((char*)d_ws + WS_CTL, 0, CTL_BYTES, stream);
    Args a{};
    for (int i = 0; i < 28; ++i) a.in[i] = (const float*)d_in[i];
    a.out = (float*)d_out; a.ws = (unsigned char*)d_ws;
#if N_LAUNCH_MODE == 0
    a.ph_lo = 0; a.ph_hi = NPHASE;
    hipLaunchKernelGGL(mega, dim3(grid), dim3(512), LDS_BYTES, stream, a);
#else
    for (int p = 0; p < NPHASE; ++p) { a.ph_lo = p; a.ph_hi = p + 1; hipLaunchKernelGGL(mega, dim3(grid), dim3(512), LDS_BYTES, stream, a); }
#endif
}
```

```cpp
#include <hip/hip_runtime.h>
#include <cstdio>
#include <cstdint>

#ifndef PROBE_MASK
#define PROBE_MASK 0
#endif
#define RUNPH(bit, ...) do { __VA_ARGS__ if constexpr (((PROBE_MASK >> (bit)) & 1) != 0) { __VA_ARGS__ } } while (0)
#ifndef RW_REP_AB
#define RW_REP_AB 1
#endif
#ifndef RW_REP_EW
#define RW_REP_EW 1
#endif
#ifndef MOE_FP8
#define MOE_FP8 1
#endif
#ifndef GLA_FAST
#define GLA_FAST 1
#endif
#ifndef RWKV_FAST
#define RWKV_FAST 1
#endif
#ifndef N_LAUNCH_MODE
#define N_LAUNCH_MODE 0
#endif

#define LAS __attribute__((address_space(3)))
typedef unsigned short bf16_t;
typedef short bf16x8 __attribute__((ext_vector_type(8)));
typedef float f32x4 __attribute__((ext_vector_type(4)));
typedef float f32x2 __attribute__((ext_vector_type(2)));
typedef unsigned u32x4 __attribute__((ext_vector_type(4)));
typedef unsigned u32x2 __attribute__((ext_vector_type(2)));
typedef int i32x8 __attribute__((ext_vector_type(8)));
typedef int i32x4_ __attribute__((ext_vector_type(4)));

constexpr int DM = 1024, SEQ = 4096, TH = 32768  , NBH = 8  ;
constexpr int ZLD = 8704;
constexpr int ZQ = 0, ZK = 512, ZV = 1024, ZOG = 2048, ZR = 3072, ZK2 = 4096, ZV2 = 5120, ZGA = 6144, ZGB = 7168, ZXW = 8192, ZXA = 8256, ZXG = 8320, ZGL = 8448;
constexpr int NEXP = 32, NROWS = 139264  , NBLK_MAX = 544;
constexpr int LDS_BYTES = 160 * 1024;
constexpr int MISC_OFF = LDS_BYTES - 256;

constexpr size_t WS_CTL = 0, CTL_BYTES = 65536;
constexpr size_t WS_WIN = WS_CTL + CTL_BYTES;
constexpr size_t WS_WA = WS_WIN + (size_t)ZLD * 1024 * 2;
constexpr size_t WS_WB = WS_WA + 2097152, WS_WO = WS_WB + 2097152;
constexpr size_t WS_W1 = WS_WO + 2097152;
constexpr size_t WS_W2 = WS_W1 + (size_t)32 * 2048 * 1024 * 2;
constexpr size_t WS_H = WS_W2 + (size_t)32 * 1024 * 1024 * 2;
constexpr size_t WS_Z = WS_H + (size_t)TH * 1024 * 2;
constexpr size_t WS_YB = WS_Z + (size_t)TH * ZLD * 2;
constexpr size_t WS_MG = WS_YB + (size_t)TH * 1024 * 2;
constexpr size_t WS_H2 = WS_MG + (size_t)TH * 1024 * 2;
constexpr size_t WS_RTOK = WS_H2 + (size_t)TH * 1024 * 2;
constexpr size_t WS_RGATE = WS_RTOK + (size_t)NROWS * 4;
constexpr size_t WS_DEST = WS_RGATE + (size_t)NROWS * 4;
constexpr size_t WS_TOPE = WS_DEST + (size_t)TH * 16;
constexpr size_t WS_TOPG = WS_TOPE + (size_t)TH * 16;
constexpr size_t WS_BLKE = WS_TOPG + (size_t)TH * 16;
constexpr size_t WS_END = WS_BLKE + 4096;
constexpr size_t WS_ACT = WS_Z, WS_OUTS = WS_Z + (size_t)NROWS * 1024 * 2;
static_assert(WS_OUTS + (size_t)NROWS * 1024 * 2 <= WS_YB, "ACT/OUTS overlay");
constexpr int CW_CNT = 4096, CW_CUR = 4352, CW_NBLK = 4608;

__device__ __forceinline__ unsigned pk4_fp8(float a, float b, float c, float d) { int r = __builtin_amdgcn_cvt_pk_fp8_f32(a, b, 0, false); r = __builtin_amdgcn_cvt_pk_fp8_f32(c, d, r, true); return (unsigned)r; }
__device__ __forceinline__ float bf2f(unsigned short b) { return __uint_as_float(((unsigned)b) << 16); }
__device__ __forceinline__ float bflo(unsigned w) { return __uint_as_float(w << 16); }
__device__ __forceinline__ float bfhi(unsigned w) { return __uint_as_float(w & 0xffff0000u); }
typedef __bf16 bf16x2v __attribute__((ext_vector_type(2)));
__device__ __forceinline__ unsigned pk2(float lo, float hi) { f32x2 v = {lo, hi}; return __builtin_bit_cast(unsigned, __builtin_convertvector(v, bf16x2v)); }
__device__ __forceinline__ unsigned short f2bf(float f) { return (unsigned short)(pk2(f, 0.f) & 0xffffu); }
template <int CTRL> __device__ __forceinline__ float dpp_f(float x) { return __int_as_float(__builtin_amdgcn_update_dpp(0, __float_as_int(x), CTRL, 0xF, 0xF, true)); }
__device__ __forceinline__ float rowsum16(float x) {
    x += dpp_f<0xB1>(x); x += dpp_f<0x4E>(x); x += dpp_f<0x141>(x); x += dpp_f<0x140>(x); return x;
}
__device__ __forceinline__ float wave_sum(float v) {
    v = rowsum16(v);
    const int iv = __float_as_int(v);
    return (__int_as_float(__builtin_amdgcn_readlane(iv, 0)) + __int_as_float(__builtin_amdgcn_readlane(iv, 16))) + (__int_as_float(__builtin_amdgcn_readlane(iv, 32)) + __int_as_float(__builtin_amdgcn_readlane(iv, 48)));
}
__device__ __forceinline__ float frcp(float x) { return __builtin_amdgcn_rcpf(x); }
__device__ __forceinline__ float wave_max(float v) {
#pragma unroll
    for (int o = 32; o > 0; o >>= 1) v = fmaxf(v, __shfl_xor(v, o));
    return v;
}
__device__ __forceinline__ int wave_min_i(int v) {
#pragma unroll
    for (int o = 32; o > 0; o >>= 1) { int w = __shfl_xor(v, o); v = w < v ? w : v; }
    return v;
}
__device__ __forceinline__ float sigmoidf_(float x) { return frcp(1.0f + __expf(-x)); }
__device__ __forceinline__ float tanhf_(float x) { return 1.0f - 2.0f * frcp(1.0f + __expf(2.0f * x)); }
__device__ __forceinline__ float softplusf_(float y) { return fmaxf(y, 0.f) + 0.6931471805599453f * __builtin_amdgcn_logf(1.0f + __expf(-fabsf(y))); }

#define XB_TMO      128
#define XB_XCNT(j)  (256  + 64 * (j))
#define XB_XSUB(j)  (1280 + 64 * (j))
#define XB_XGEN(j)  (2304 + 64 * (j))
#define XB_TOP      3328
#define XB_TOPGEN   3392
#define XCD_BAR_WORDS 3456
#define XB_SPIN_CAP (1u << 22)
__device__ __forceinline__ unsigned xb_ld(unsigned* p)              { return __hip_atomic_load(p, __ATOMIC_RELAXED, __HIP_MEMORY_SCOPE_AGENT); }
__device__ __forceinline__ unsigned xb_add(unsigned* p, unsigned v) { return __hip_atomic_fetch_add(p, v, __ATOMIC_RELAXED, __HIP_MEMORY_SCOPE_AGENT); }
__device__ __forceinline__ unsigned xb_xcc_id() { return (unsigned)__builtin_amdgcn_s_getreg((3 << 11) | 20) & 0xFu; }
#define XB_SPIN(cond, bar) do { unsigned _sp = 0; while (cond) { __builtin_amdgcn_s_sleep(1); \
    if ((++_sp & 255u) == 0u) { if (xb_ld(&(bar)[XB_TMO])) break; if (_sp > XB_SPIN_CAP) { atomicAdd(&(bar)[XB_TMO], 1u); break; } } } } while (0)
struct XcdBarrier { unsigned* bar; unsigned x; volatile LAS unsigned* st; };
__device__ __forceinline__ XcdBarrier xcd_barrier_post(unsigned* bar, volatile LAS unsigned* st) {
    XcdBarrier b; b.bar = bar; b.x = xb_xcc_id(); b.st = st;
    if (threadIdx.x == 0) (void)xb_add(&bar[XB_XCNT(b.x)], 1u);
    return b;
}
__device__ __forceinline__ void xcd_barrier_complete(unsigned* bar, unsigned x, unsigned& nloc, unsigned& nx) {
    const unsigned G = gridDim.x * gridDim.y * gridDim.z;
    unsigned sum, cnt, mine, sp = 0u;
    for (;;) {
        sum = 0u; cnt = 0u; mine = 0u;
#pragma unroll
        for (unsigned j = 0; j < 16; ++j) { const unsigned c = xb_ld(&bar[XB_XCNT(j)]); sum += c; cnt += (c > 0u) ? 1u : 0u; mine = (j == x) ? c : mine; }
        if (sum == G) break;
        __builtin_amdgcn_s_sleep(1);
        if ((++sp & 255u) == 0u) { if (xb_ld(&bar[XB_TMO])) break; if (sp > XB_SPIN_CAP) { atomicAdd(&bar[XB_TMO], 1u); break; } }
    }
    nloc = mine > 0u ? mine : 1u; nx = cnt > 0u ? cnt : 1u;
}
__device__ __forceinline__ void xcd_barrier(const XcdBarrier& b) {
    asm volatile("s_waitcnt vmcnt(0)" ::: "memory");
    __syncthreads();
    if (threadIdx.x == 0) {
        unsigned* bar = b.bar;
        __builtin_amdgcn_s_waitcnt(0);
        unsigned nloc = b.st[0], nx = b.st[1];
        if (nloc == 0u) { xcd_barrier_complete(bar, b.x, nloc, nx); b.st[0] = nloc; b.st[1] = nx; }
        const unsigned old = xb_add(&bar[XB_XSUB(b.x)], 1u);
        const unsigned gen = old / nloc;
        if (old + 1u == (gen + 1u) * nloc) {
            __builtin_amdgcn_fence(__ATOMIC_RELEASE, "agent");
            asm volatile("s_waitcnt vmcnt(0)" ::: "memory");
            const unsigned og = xb_add(&bar[XB_TOP], 1u);
            const unsigned tg = og / nx;
            if (og + 1u == (tg + 1u) * nx) xb_add(&bar[XB_TOPGEN], 1u);
            else XB_SPIN(xb_ld(&bar[XB_TOPGEN]) == tg, bar);
            __builtin_amdgcn_fence(__ATOMIC_ACQUIRE, "agent");
            xb_add(&bar[XB_XGEN(b.x)], 1u);
            asm volatile("s_waitcnt vmcnt(0)" ::: "memory");
        } else {
            XB_SPIN(xb_ld(&bar[XB_XGEN(b.x)]) == gen, bar);
            __builtin_amdgcn_fence(__ATOMIC_ACQUIRE, "agent");
            asm volatile("s_waitcnt vmcnt(0)" ::: "memory");
        }
    }
    __syncthreads();
}

namespace pg8 {
constexpr int BM = 256, BK = 64, HALF = 128, HTB = HALF * BK * 2, STAGE_BYTES = 8 * HTB, NXCD = 8, WGM = 8;
__host__ __device__ __forceinline__ int lds_byte(int r, int c) { const int st = (r >> 4) * 2 + (c >> 5), rr = r & 15, cc = c & 31, ob = rr * 64 + cc * 2; return st * 1024 + (ob ^ (((ob >> 9) & 1) << 5)); }
__host__ __device__ __forceinline__ void stage_rc(int b, int& R, int& C) { const int st = b / 1024, sb = b % 1024, swz = sb ^ (((sb >> 9) & 1) << 5); R = (st >> 1) * 16 + swz / 64; C = (st & 1) * 32 + (swz % 64) / 2; }
__host__ __device__ __forceinline__ int perm32(int rho) { const int n = rho >> 4, i = rho & 15; return 8 * (i >> 2) + 4 * n + (i & 3); }
struct Unit { int pm, pn; };
struct Gemm { const bf16_t* A; const bf16_t* Bt; int K; };

struct StaticOrder {
    static constexpr bool GATHER = false;
    int nM, nN, nwg, G, c;
    __device__ void init(int M, int N, int G_, int c_) { nM = M / BM; nN = N / BM; nwg = nM * nN; G = G_; c = c_; }
    __device__ bool next(int i, Unit& u) const {
        const long L = (long)i * G + c; if (L >= nwg) return false;
        int wgid = (int)L; { const int q = nwg / NXCD, r = nwg % NXCD, xcd = wgid % NXCD, off = wgid / NXCD; wgid = (xcd < r ? xcd * (q + 1) : r * (q + 1) + (xcd - r) * q) + off; }
        const int nig = WGM * nN, gid = wgid / nig, fm = gid * WGM, gsz = (nM - fm) < WGM ? (nM - fm) : WGM;
        u.pm = fm + ((wgid % nig) % gsz); u.pn = (wgid % nig) / gsz; return true;
    }
    __device__ __forceinline__ int arow(const Unit& u, int r) const { return u.pm * BM + r; }
};
template <bool GATHER_, bool IDENT_ = false> struct MoeOrder {
    static constexpr bool GATHER = GATHER_ || IDENT_;
    int nunits, G, c, sh, ncol; const int* blke; const int* rtok;
    __device__ bool next(int i, Unit& u) const {
        const int x = c & 7, w = c >> 3, bpr = G >> sh, bpx = bpr >> 3;
        const int blk = i * bpr + x * bpx + (w >> sh), pnl = w & (ncol - 1);
        if (blk * ncol >= nunits) return false;
        const int e = blke[blk];
        u.pm = blk; u.pn = e * ncol + pnl; return true;
    }
    __device__ __forceinline__ int arow(const Unit& u, int r) const { return (GATHER_ && !IDENT_) ? rtok[u.pm * BM + r] : u.pm * BM + r; }
};

__device__ __forceinline__ unsigned cvt_pk_bf16(float lo, float hi) { unsigned r; asm volatile("v_cvt_pk_bf16_f32 %0, %1, %2" : "=v"(r) : "v"(lo), "v"(hi)); return r; }

struct EpiZ {
    static constexpr bool PERM = true; static constexpr bool F8 = false;
    bf16_t* O; int ldc;
    __device__ __forceinline__ void operator()(const f32x4 (&acc)[2][2][4][2], const Unit& u, int wr, int wc, int fr, int fq) const {
        const unsigned row0 = u.pm * BM + wr * 64 + fr, col0 = u.pn * BM + wc * 32 + 8 * fq;
        const unsigned b0 = (row0 * (unsigned)ldc + col0) * 2u;
#pragma unroll
        for (int ai = 0; ai < 2; ++ai)
#pragma unroll
            for (int m = 0; m < 4; ++m) { const unsigned rb = b0 + (unsigned)((ai * HALF + m * 16) * 2) * (unsigned)ldc;
#pragma unroll
                for (int bj = 0; bj < 2; ++bj) { const f32x4 v0 = acc[ai][bj][m][0], v1 = acc[ai][bj][m][1];
                    u32x4 w; w.x = cvt_pk_bf16(v0[0], v0[1]); w.y = cvt_pk_bf16(v0[2], v0[3]); w.z = cvt_pk_bf16(v1[0], v1[1]); w.w = cvt_pk_bf16(v1[2], v1[3]);
                    *(u32x4*)((char*)O + (rb + (unsigned)(bj * HALF * 2))) = w; } }
    }
};
template <bool FIRST> struct EpiGate {
    static constexpr bool PERM = true; static constexpr bool F8 = false;
    const bf16_t* Z; int gcol; bf16_t* MG;
    __device__ __forceinline__ void operator()(const f32x4 (&acc)[2][2][4][2], const Unit& u, int wr, int wc, int fr, int fq) const {
        const int row0 = u.pm * BM + wr * 64 + fr, col0 = u.pn * BM + wc * 32 + 8 * fq;
#pragma unroll
        for (int ai = 0; ai < 2; ++ai)
#pragma unroll
            for (int m = 0; m < 4; ++m) { const int row = row0 + ai * HALF + m * 16; const bf16_t* zr = Z + (size_t)row * ZLD + gcol + col0; bf16_t* mg = MG + (size_t)row * DM + col0;
#pragma unroll
                for (int bj = 0; bj < 2; ++bj) { const f32x4 v0 = acc[ai][bj][m][0], v1 = acc[ai][bj][m][1];
                    const u32x4 g = *(const u32x4*)(zr + bj * HALF);
                    float r[8];
                    r[0] = sigmoidf_(bflo(g.x)) * v0[0]; r[1] = sigmoidf_(bfhi(g.x)) * v0[1]; r[2] = sigmoidf_(bflo(g.y)) * v0[2]; r[3] = sigmoidf_(bfhi(g.y)) * v0[3];
                    r[4] = sigmoidf_(bflo(g.z)) * v1[0]; r[5] = sigmoidf_(bfhi(g.z)) * v1[1]; r[6] = sigmoidf_(bflo(g.w)) * v1[2]; r[7] = sigmoidf_(bfhi(g.w)) * v1[3];
                    if (!FIRST) { const u32x4 p = *(const u32x4*)(mg + bj * HALF);
                        r[0] += bflo(p.x); r[1] += bfhi(p.x); r[2] += bflo(p.y); r[3] += bfhi(p.y); r[4] += bflo(p.z); r[5] += bfhi(p.z); r[6] += bflo(p.w); r[7] += bfhi(p.w); }
                    u32x4 w; w.x = cvt_pk_bf16(r[0], r[1]); w.y = cvt_pk_bf16(r[2], r[3]); w.z = cvt_pk_bf16(r[4], r[5]); w.w = cvt_pk_bf16(r[6], r[7]);
                    *(u32x4*)(mg + bj * HALF) = w; } }
    }
};
struct EpiRes {
    static constexpr bool PERM = false; static constexpr bool F8 = false;
    const float* base; float* out;
    __device__ __forceinline__ void operator()(const f32x4 (&acc)[2][2][4][2], const Unit& u, int wr, int wc, int fr, int fq) const {
        const int row0 = u.pm * BM + wr * 64 + fr, col0 = u.pn * BM + wc * 32 + 4 * fq;
#pragma unroll
        for (int ai = 0; ai < 2; ++ai)
#pragma unroll
            for (int m = 0; m < 4; ++m) { const size_t off = (size_t)(row0 + ai * HALF + m * 16) * DM + col0;
#pragma unroll
                for (int bj = 0; bj < 2; ++bj)
#pragma unroll
                    for (int n = 0; n < 2; ++n) { const f32x4 b = *(const f32x4*)(base + off + bj * HALF + n * 16); *(f32x4*)(out + off + bj * HALF + n * 16) = b + acc[ai][bj][m][n]; }
                asm volatile("" ::: "memory"); }
    }
};
struct EpiSwiglu {
    static constexpr bool PERM = true; static constexpr bool F8 = false;
    const float* b1; bf16_t* ACT;
    __device__ __forceinline__ void operator()(const f32x4 (&acc)[2][2][4][2], const Unit& u, int wr, int wc, int fr, int fq) const {
        const int e = u.pn >> 3, pnl = u.pn & 7;
        const int row0 = u.pm * BM + wr * 64 + fr, col0 = pnl * BM + wc * 32 + 8 * fq;
        const float* bp = b1 + (size_t)e * 2048 + col0;
        f32x4 bv[2][2];
#pragma unroll
        for (int bj = 0; bj < 2; ++bj)
#pragma unroll
            for (int n = 0; n < 2; ++n) bv[bj][n] = *(const f32x4*)(bp + bj * HALF + 4 * n);
#pragma unroll
        for (int ai = 0; ai < 2; ++ai)
#pragma unroll
            for (int m = 0; m < 4; ++m) { bf16_t* rowp = ACT + (size_t)(row0 + ai * HALF + m * 16) * DM + (col0 >> 1);
#pragma unroll
                for (int bj = 0; bj < 2; ++bj) { const f32x4 v0 = acc[ai][bj][m][0] + bv[bj][0], v1 = acc[ai][bj][m][1] + bv[bj][1];
                    float o[4];
                    { const float gl = fminf(v0[0], 7.0f), ln = fminf(fmaxf(v0[1], -7.0f), 7.0f); o[0] = gl * sigmoidf_(1.702f * gl) * (ln + 1.0f); }
                    { const float gl = fminf(v0[2], 7.0f), ln = fminf(fmaxf(v0[3], -7.0f), 7.0f); o[1] = gl * sigmoidf_(1.702f * gl) * (ln + 1.0f); }
                    { const float gl = fminf(v1[0], 7.0f), ln = fminf(fmaxf(v1[1], -7.0f), 7.0f); o[2] = gl * sigmoidf_(1.702f * gl) * (ln + 1.0f); }
                    { const float gl = fminf(v1[2], 7.0f), ln = fminf(fmaxf(v1[3], -7.0f), 7.0f); o[3] = gl * sigmoidf_(1.702f * gl) * (ln + 1.0f); }
                    u32x2 w; w.x = cvt_pk_bf16(o[0], o[1]); w.y = cvt_pk_bf16(o[2], o[3]);
                    *(u32x2*)(rowp + bj * (HALF / 2)) = w; } }
    }
};
struct EpiMoe2 {
    static constexpr bool PERM = true; static constexpr bool F8 = false;
    const float* b2; const float* rgate; bf16_t* O;
    __device__ __forceinline__ void operator()(const f32x4 (&acc)[2][2][4][2], const Unit& u, int wr, int wc, int fr, int fq) const {
        const int e = u.pn >> 2, pnl = u.pn & 3;
        const int row0 = u.pm * BM + wr * 64 + fr, col0 = pnl * BM + wc * 32 + 8 * fq;
        const float* bp = b2 + (size_t)e * 1024 + col0;
        f32x4 bv[2][2];
#pragma unroll
        for (int bj = 0; bj < 2; ++bj)
#pragma unroll
            for (int n = 0; n < 2; ++n) bv[bj][n] = *(const f32x4*)(bp + bj * HALF + 4 * n);
#pragma unroll
        for (int ai = 0; ai < 2; ++ai)
#pragma unroll
            for (int m = 0; m < 4; ++m) { const int row = row0 + ai * HALF + m * 16; const float gt = rgate[row]; bf16_t* rowp = O + (size_t)row * DM + col0;
#pragma unroll
                for (int bj = 0; bj < 2; ++bj) { const f32x4 v0 = (acc[ai][bj][m][0] + bv[bj][0]) * gt, v1 = (acc[ai][bj][m][1] + bv[bj][1]) * gt;
                    u32x4 w; w.x = cvt_pk_bf16(v0[0], v0[1]); w.y = cvt_pk_bf16(v0[2], v0[3]); w.z = cvt_pk_bf16(v1[0], v1[1]); w.w = cvt_pk_bf16(v1[2], v1[3]);
                    *(u32x4*)(rowp + bj * HALF) = w; } }
    }
};
struct EpiSwiglu8 {
    static constexpr bool PERM = true; static constexpr bool F8 = true;
    const float* b1; unsigned char* ACT;
    __device__ __forceinline__ void operator()(const f32x4 (&acc)[2][2][4][2], const Unit& u, int wr, int wc, int fr, int fq) const {
        const int e = u.pn >> 3, pnl = u.pn & 7;
        const int row0 = u.pm * BM + wr * 64 + fr, col0 = pnl * BM + wc * 32 + 8 * fq;
        const float* bp = b1 + (size_t)e * 2048 + col0;
        f32x4 bv[2][2];
#pragma unroll
        for (int bj = 0; bj < 2; ++bj)
#pragma unroll
            for (int n = 0; n < 2; ++n) bv[bj][n] = *(const f32x4*)(bp + bj * HALF + 4 * n);
#pragma unroll
        for (int ai = 0; ai < 2; ++ai)
#pragma unroll
            for (int m = 0; m < 4; ++m) { unsigned char* rowp = ACT + (size_t)(row0 + ai * HALF + m * 16) * DM + (col0 >> 1);
#pragma unroll
                for (int bj = 0; bj < 2; ++bj) { const f32x4 v0 = acc[ai][bj][m][0] * 0.015625f + bv[bj][0], v1 = acc[ai][bj][m][1] * 0.015625f + bv[bj][1];
                    float o[4];
                    { const float gl = fminf(v0[0], 7.0f), ln = fminf(fmaxf(v0[1], -7.0f), 7.0f); o[0] = gl * sigmoidf_(1.702f * gl) * (ln + 1.0f); }
                    { const float gl = fminf(v0[2], 7.0f), ln = fminf(fmaxf(v0[3], -7.0f), 7.0f); o[1] = gl * sigmoidf_(1.702f * gl) * (ln + 1.0f); }
                    { const float gl = fminf(v1[0], 7.0f), ln = fminf(fmaxf(v1[1], -7.0f), 7.0f); o[2] = gl * sigmoidf_(1.702f * gl) * (ln + 1.0f); }
                    { const float gl = fminf(v1[2], 7.0f), ln = fminf(fmaxf(v1[3], -7.0f), 7.0f); o[3] = gl * sigmoidf_(1.702f * gl) * (ln + 1.0f); }
                    *(unsigned*)(rowp + bj * (HALF / 2)) = pk4_fp8(o[0], o[1], o[2], o[3]); } }
    }
};
struct EpiMoe2_8 {
    static constexpr bool PERM = true; static constexpr bool F8 = true;
    const float* b2; const float* rgate; bf16_t* O;
    __device__ __forceinline__ void operator()(const f32x4 (&acc)[2][2][4][2], const Unit& u, int wr, int wc, int fr, int fq) const {
        const int e = u.pn >> 2, pnl = u.pn & 3;
        const int row0 = u.pm * BM + wr * 64 + fr, col0 = pnl * BM + wc * 32 + 8 * fq;
        const float* bp = b2 + (size_t)e * 1024 + col0;
        f32x4 bv[2][2];
#pragma unroll
        for (int bj = 0; bj < 2; ++bj)
#pragma unroll
            for (int n = 0; n < 2; ++n) bv[bj][n] = *(const f32x4*)(bp + bj * HALF + 4 * n);
#pragma unroll
        for (int ai = 0; ai < 2; ++ai)
#pragma unroll
            for (int m = 0; m < 4; ++m) { const int row = row0 + ai * HALF + m * 16; const float gt = rgate[row]; bf16_t* rowp = O + (size_t)row * DM + col0;
#pragma unroll
                for (int bj = 0; bj < 2; ++bj) { const f32x4 v0 = (acc[ai][bj][m][0] * 0.015625f + bv[bj][0]) * gt, v1 = (acc[ai][bj][m][1] * 0.015625f + bv[bj][1]) * gt;
                    u32x4 w; w.x = cvt_pk_bf16(v0[0], v0[1]); w.y = cvt_pk_bf16(v0[2], v0[3]); w.z = cvt_pk_bf16(v1[0], v1[1]); w.w = cvt_pk_bf16(v1[2], v1[3]);
                    *(u32x4*)(rowp + bj * HALF) = w; }
                asm volatile("" ::: "memory"); }
    }
};

template <class Epi, class Sched>
__device__ __forceinline__ void gemm_phase(LAS unsigned char* lds, const Gemm g, const Sched& S, const Epi& E) {
    const int tid = threadIdx.x, wid = __builtin_amdgcn_readfirstlane(tid >> 6), lane = tid & 63, wr = wid >> 2, wc = wid & 3, fr = lane & 15, fq = lane >> 4;
    const int K = g.K, nt = K / BK;
    constexpr bool GA = Sched::GATHER; constexpr bool F8 = Epi::F8;
    unsigned voffA[2], voffB[2];
#pragma unroll
    for (int i = 0; i < 2; ++i) { int R, C; stage_rc(tid * 16 + i * 8192, R, C); const int Rb = Epi::PERM ? ((R & ~31) + perm32(R & 31)) : R;
        voffA[i] = GA ? (unsigned)C * 2u : (unsigned)(R * K + C) * 2u; voffB[i] = (unsigned)(Rb * K + C) * 2u; }
    const size_t kstep = (size_t)(BK * 2);
    const size_t hstep = (size_t)HALF * K * 2;
    const size_t tstep = 2 * hstep;
    const unsigned ldsw = (unsigned)wid * 1024u;
    const int aoff = lds_byte(wr * 64 + fr, F8 ? fq * 16 : fq * 8), boff = lds_byte(wc * 32 + fr, F8 ? fq * 16 : fq * 8);
#define PG8_SA(b, h) (((b) * 2 + (h)) * HTB)
#define PG8_SB(b, h) ((4 + (b) * 2 + (h)) * HTB)
#define PG8_STAGE(bufoff, gbase, voff) do { _Pragma("unroll") for (int _i = 0; _i < 2; ++_i) \
        __builtin_amdgcn_global_load_lds((const unsigned*)((const char*)(gbase) + (voff)[_i]), (LAS unsigned*)(lds + (bufoff) + ldsw + _i * 8192), 16, 0, 0); } while (0)
#define PG8_STAGEA(bufoff, pA, kb, h) do { if constexpr (GA) { \
            __builtin_amdgcn_global_load_lds((const unsigned*)((const char*)g.A + (kb) + og[h][0]), (LAS unsigned*)(lds + (bufoff) + ldsw), 16, 0, 0); \
            __builtin_amdgcn_global_load_lds((const unsigned*)((const char*)g.A + (kb) + og[h][1]), (LAS unsigned*)(lds + (bufoff) + ldsw + 8192), 16, 0, 0); \
        } else { PG8_STAGE(bufoff, (pA) + (h) * hstep, voffA); } } while (0)
#define PG8_ROWS(u, dst) do { _Pragma("unroll") for (int _h = 0; _h < 2; ++_h) _Pragma("unroll") for (int _i = 0; _i < 2; ++_i) { int R_, C_; stage_rc(tid * 16 + _i * 8192, R_, C_); \
        dst[_h][_i] = (unsigned)S.arow(u, _h * HALF + R_) * (unsigned)(K * 2) + voffA[_i]; } } while (0)
#define PG8_LDA(dst, b, h) do { if constexpr (F8) { _Pragma("unroll") for (int m = 0; m < 4; ++m) _Pragma("unroll") for (int k = 0; k < 2; ++k) dst[m][k] = *(const LAS bf16x8*)(lds + PG8_SA(b, h) + aoff + m * 2048 + k * 16); } \
        else { _Pragma("unroll") for (int m = 0; m < 4; ++m) _Pragma("unroll") for (int k = 0; k < 2; ++k) dst[m][k] = *(const LAS bf16x8*)(lds + PG8_SA(b, h) + aoff + m * 2048 + k * 1024); } } while (0)
#define PG8_LDB(dst, b, h) do { if constexpr (F8) { _Pragma("unroll") for (int n = 0; n < 2; ++n) _Pragma("unroll") for (int k = 0; k < 2; ++k) dst[n][k] = *(const LAS bf16x8*)(lds + PG8_SB(b, h) + boff + n * 2048 + k * 16); } \
        else { _Pragma("unroll") for (int n = 0; n < 2; ++n) _Pragma("unroll") for (int k = 0; k < 2; ++k) dst[n][k] = *(const LAS bf16x8*)(lds + PG8_SB(b, h) + boff + n * 2048 + k * 1024); } } while (0)
#define PG8_F8CAT(x) __builtin_shufflevector(__builtin_bit_cast(i32x4_, (x)[0]), __builtin_bit_cast(i32x4_, (x)[1]), 0, 1, 2, 3, 4, 5, 6, 7)
#define PG8_MMA(ai, bj, At, Bt) do { __builtin_amdgcn_s_setprio(1); if constexpr (F8) { _Pragma("unroll") for (int m = 0; m < 4; ++m) _Pragma("unroll") for (int n = 0; n < 2; ++n) \
        acc[ai][bj][m][n] = __builtin_amdgcn_mfma_scale_f32_16x16x128_f8f6f4(PG8_F8CAT(Bt[n]), PG8_F8CAT(At[m]), acc[ai][bj][m][n], 0, 0, 0, 0x7F7F7F7F, 0, 0x7F7F7F7F); } \
    else { _Pragma("unroll") for (int m = 0; m < 4; ++m) _Pragma("unroll") for (int n = 0; n < 2; ++n) _Pragma("unroll") for (int k = 0; k < 2; ++k) \
        acc[ai][bj][m][n] = __builtin_amdgcn_mfma_f32_16x16x32_bf16(Bt[n][k], At[m][k], acc[ai][bj][m][n], 0, 0, 0); } __builtin_amdgcn_s_setprio(0); } while (0)
#define PG8_WAIT_V(n) asm volatile("s_waitcnt vmcnt(" #n ")" ::: "memory")
#define PG8_WAIT_L(n) asm volatile("s_waitcnt lgkmcnt(" #n ")" ::: "memory")
#define PG8_BAR __builtin_amdgcn_s_barrier()
#define PG8_SCHED __builtin_amdgcn_sched_barrier(0)
    Unit cur, nxt; int ui = 0;
    if (!S.next(0, cur)) return;
    f32x4 acc[2][2][4][2];
#pragma unroll
    for (int a = 0; a < 2; ++a)
#pragma unroll
        for (int b = 0; b < 2; ++b)
#pragma unroll
            for (int m = 0; m < 4; ++m)
#pragma unroll
                for (int n = 0; n < 2; ++n) acc[a][b][m][n] = (f32x4){0.f, 0.f, 0.f, 0.f};
    bf16x8 At[4][2], B0[2][2], B1[2][2];
    unsigned og[2][2], ogn[2][2];
    const char* cA = GA ? (const char*)nullptr : (const char*)g.A + (size_t)cur.pm * tstep; const char* cB = (const char*)g.Bt + (size_t)cur.pn * tstep;
    if constexpr (GA) { PG8_ROWS(cur, og); }
    PG8_STAGE(PG8_SB(0, 0), cB, voffB); PG8_STAGE(PG8_SB(0, 1), cB + hstep, voffB); PG8_STAGEA(PG8_SA(0, 0), cA, 0, 0); PG8_STAGEA(PG8_SA(0, 1), cA, 0, 1);
    if (wr == 1) PG8_BAR;
    PG8_WAIT_V(2); PG8_BAR;
    PG8_STAGE(PG8_SB(1, 0), cB + kstep, voffB); PG8_STAGEA(PG8_SA(1, 0), cA + kstep, (unsigned)(BK * 2), 0); PG8_STAGE(PG8_SB(1, 1), cB + hstep + kstep, voffB);
    PG8_WAIT_V(6); PG8_BAR;
    for (;;) {
        const bool has_next = S.next(ui + 1, nxt);
        const char* nA = GA ? (const char*)nullptr : (has_next ? (const char*)g.A + (size_t)nxt.pm * tstep : cA); const char* nB = has_next ? (const char*)g.Bt + (size_t)nxt.pn * tstep : cB;
        if constexpr (GA) { if (has_next) { PG8_ROWS(nxt, ogn); } else {
#pragma unroll
            for (int _h = 0; _h < 2; ++_h)
#pragma unroll
                for (int _i = 0; _i < 2; ++_i) ogn[_h][_i] = og[_h][_i]; } }
#pragma unroll 1
        for (int t = 0; t < nt; t += 2) {
            const bool last = (t == nt - 2);
            const char* a1 = cA + (size_t)(t + 1) * kstep;
            const char* a2 = last ? nA : cA + (size_t)(t + 2) * kstep; const char* b2 = last ? nB : cB + (size_t)(t + 2) * kstep;
            const char* a3 = a2 + kstep; const char* b3 = b2 + kstep;
            const unsigned ka1 = (unsigned)(t + 1) * (unsigned)(BK * 2), ka2 = last ? 0u : (unsigned)(t + 2) * (unsigned)(BK * 2), ka3 = ka2 + (unsigned)(BK * 2);
            PG8_LDB(B0, 0, 0); PG8_LDB(B1, 0, 1); PG8_SCHED; PG8_LDA(At, 0, 0); PG8_STAGEA(PG8_SA(1, 1), a1, ka1, 1);
            if constexpr (GA) { if (last) {
#pragma unroll
                for (int _h = 0; _h < 2; ++_h)
#pragma unroll
                    for (int _i = 0; _i < 2; ++_i) og[_h][_i] = ogn[_h][_i]; } }
            PG8_WAIT_V(8); PG8_WAIT_L(0); PG8_BAR; PG8_MMA(0, 0, At, B0); PG8_MMA(0, 1, At, B1); PG8_BAR; PG8_SCHED;
            PG8_LDA(At, 0, 1); PG8_STAGE(PG8_SB(0, 0), b2, voffB); PG8_STAGE(PG8_SB(0, 1), b2 + hstep, voffB); PG8_STAGEA(PG8_SA(0, 0), a2, ka2, 0);
            PG8_WAIT_V(8); PG8_WAIT_L(0); PG8_BAR; PG8_MMA(1, 0, At, B0); PG8_MMA(1, 1, At, B1); PG8_BAR; PG8_SCHED;
            PG8_LDB(B0, 1, 0); PG8_LDB(B1, 1, 1); PG8_SCHED; PG8_LDA(At, 1, 0); PG8_STAGEA(PG8_SA(0, 1), a2, ka2, 1);
            PG8_WAIT_V(8); PG8_WAIT_L(0); PG8_BAR; PG8_MMA(0, 0, At, B0); PG8_MMA(0, 1, At, B1); PG8_BAR; PG8_SCHED;
            PG8_LDA(At, 1, 1); PG8_STAGE(PG8_SB(1, 0), b3, voffB); PG8_STAGE(PG8_SB(1, 1), b3 + hstep, voffB); PG8_STAGEA(PG8_SA(1, 0), a3, ka3, 0);
            PG8_WAIT_V(8); PG8_WAIT_L(0); PG8_BAR; PG8_MMA(1, 0, At, B0); PG8_MMA(1, 1, At, B1); PG8_BAR; PG8_SCHED;
        }
        if (wr == 0) PG8_BAR;
        E(acc, cur, wr, wc, fr, fq);
        if (!has_next) break;
#pragma unroll
        for (int a = 0; a < 2; ++a)
#pragma unroll
            for (int b = 0; b < 2; ++b)
#pragma unroll
                for (int m = 0; m < 4; ++m)
#pragma unroll
                    for (int n = 0; n < 2; ++n) acc[a][b][m][n] = (f32x4){0.f, 0.f, 0.f, 0.f};
        cur = nxt; cA = nA; cB = nB; ++ui;
        if (wr == 1) PG8_BAR;
    }
    PG8_WAIT_V(0);
    PG8_BAR;
#undef PG8_SA
#undef PG8_SB
#undef PG8_STAGE
#undef PG8_STAGEA
#undef PG8_ROWS
#undef PG8_LDA
#undef PG8_LDB
#undef PG8_MMA
#undef PG8_F8CAT
#undef PG8_WAIT_V
#undef PG8_WAIT_L
#undef PG8_BAR
#undef PG8_SCHED
}
}

struct Args { const float* in[28]; float* out; unsigned char* ws; int ph_lo, ph_hi; };
enum { I_X = 0, I_NMG, I_WIN, I_GUP, I_GBIAS, I_GNG, I_MU, I_W0, I_W2, I_A0, I_A2, I_G2, I_KK, I_KA, I_RK, I_LNW, I_LNB, I_WA, I_WB, I_WO, I_NFG, I_RW, I_RB, I_EW1, I_EB1, I_EW2, I_EB2, I_NFIN };

__device__ __forceinline__ int win_orig_col(int c) {
    if (c < 2048) return c;
    if (c < 3072) return 2064 + (c - 2048);
    if (c < 6144) return 3088 + (c - 3072);
    if (c < 8192) return 6416 + (c - 6144);
    if (c < 8448) return 6160 + (c - 8192);
    if (c < 8464) return 2048 + (c - 8448);
    return -1;
}
__device__ __forceinline__ void tr_tile(const float* src, int ldsrc, bf16_t* dst, int n0, int k0, bool is_win, LAS float* tile) {
    const int tid = threadIdx.x, tx = tid & 63, ty = tid >> 6;
    const int c = n0 + tx, oc = is_win ? win_orig_col(c) : c;
#pragma unroll
    for (int kk = ty; kk < 64; kk += 8) tile[kk * 65 + tx] = oc >= 0 ? src[(size_t)(k0 + kk) * ldsrc + oc] : 0.0f;
    __syncthreads();
    const int kp = tid & 31, nn0 = tid >> 5;
#pragma unroll
    for (int nn = nn0; nn < 64; nn += 16) ((unsigned*)dst)[((size_t)(n0 + nn) * 1024 + k0) / 2 + kp] = pk2(tile[(2 * kp) * 65 + nn], tile[(2 * kp + 1) * 65 + nn]);
    __syncthreads();
}
__device__ __forceinline__ void tr_tile8(const float* src, int ldsrc, unsigned char* dst, int n0, int k0, LAS float* tile) {
    const int tid = threadIdx.x, tx = tid & 63, ty = tid >> 6;
#pragma unroll
    for (int kk = ty; kk < 64; kk += 8) tile[kk * 65 + tx] = src[(size_t)(k0 + kk) * ldsrc + n0 + tx] * 64.0f;
    __syncthreads();
    const int kp = tid & 15, nn0 = tid >> 4;
#pragma unroll
    for (int nn = nn0; nn < 64; nn += 32) *(unsigned*)(dst + (size_t)(n0 + nn) * 1024 + k0 + kp * 4) = pk4_fp8(tile[(4 * kp) * 65 + nn], tile[(4 * kp + 1) * 65 + nn], tile[(4 * kp + 2) * 65 + nn], tile[(4 * kp + 3) * 65 + nn]);
    __syncthreads();
}
constexpr int PRO_T3 = 136 * 16 + 768, PRO_T5 = PRO_T3 + 32 * 32 * 16 + 32 * 16 * 16;
__device__ __forceinline__ void prologue_phase(const Args& a, LAS unsigned char* lds, int bid, int nb, int t_lo, int t_hi) {
    LAS float* tile = (LAS float*)lds;
    unsigned char* ws = a.ws;
    constexpr int T0 = 136 * 16, T1 = T0 + 256, T2 = T1 + 256, T3 = T2 + 256, T4 = T3 + 32 * 32 * 16, T5 = T4 + 32 * 16 * 16;
    for (int t = t_lo + bid; t < t_hi; t += nb) {
        if (t < T0) { tr_tile(a.in[I_WIN], 8464, (bf16_t*)(ws + WS_WIN), (t >> 4) * 64, (t & 15) * 64, true, tile); }
        else if (t < T1) { const int q = t - T0; tr_tile(a.in[I_WA], 1024, (bf16_t*)(ws + WS_WA), (q >> 4) * 64, (q & 15) * 64, false, tile); }
        else if (t < T2) { const int q = t - T1; tr_tile(a.in[I_WB], 1024, (bf16_t*)(ws + WS_WB), (q >> 4) * 64, (q & 15) * 64, false, tile); }
        else if (t < T3) { const int q = t - T2; tr_tile(a.in[I_WO], 1024, (bf16_t*)(ws + WS_WO), (q >> 4) * 64, (q & 15) * 64, false, tile); }
        else if (t < T4) { const int q = t - T3, e = q >> 9, r = q & 511;
            if constexpr (MOE_FP8) tr_tile8(a.in[I_EW1] + (size_t)e * 1024 * 2048, 2048, (unsigned char*)(ws + WS_W1) + (size_t)e * 2048 * 1024, (r >> 4) * 64, (r & 15) * 64, tile);
            else tr_tile(a.in[I_EW1] + (size_t)e * 1024 * 2048, 2048, (bf16_t*)(ws + WS_W1) + (size_t)e * 2048 * 1024, (r >> 4) * 64, (r & 15) * 64, false, tile); }
        else { const int q = t - T4, e = q >> 8, r = q & 255;
            if constexpr (MOE_FP8) tr_tile8(a.in[I_EW2] + (size_t)e * 1024 * 1024, 1024, (unsigned char*)(ws + WS_W2) + (size_t)e * 1024 * 1024, (r >> 4) * 64, (r & 15) * 64, tile);
            else tr_tile(a.in[I_EW2] + (size_t)e * 1024 * 1024, 1024, (bf16_t*)(ws + WS_W2) + (size_t)e * 1024 * 1024, (r >> 4) * 64, (r & 15) * 64, false, tile); }
    }
}

__device__ __forceinline__ void rmsnorm_phase(const float* x, const float* gain, bf16_t* out, int bid, int nb) {
    const int lane = threadIdx.x & 63, gw = bid * 8 + (threadIdx.x >> 6), nw = nb * 8;
    for (int row = gw; row < TH; row += nw) {
        const f32x4* xr = (const f32x4*)(x + (size_t)row * DM);
        f32x4 v[4]; float ss = 0.f;
#pragma unroll
        for (int i = 0; i < 4; ++i) { v[i] = xr[i * 64 + lane]; ss += v[i][0] * v[i][0] + v[i][1] * v[i][1] + v[i][2] * v[i][2] + v[i][3] * v[i][3]; }
        ss = wave_sum(ss);
        const float rs = rsqrtf(ss * (1.0f / 1024.0f) + 1e-6f);
#pragma unroll
        for (int i = 0; i < 4; ++i) { const f32x4 g = ((const f32x4*)gain)[i * 64 + lane];
            u32x2 w; w.x = pk2(v[i][0] * rs * g[0], v[i][1] * rs * g[1]); w.y = pk2(v[i][2] * rs * g[2], v[i][3] * rs * g[3]);
            *(u32x2*)(out + (size_t)row * DM + (i * 64 + lane) * 4) = w; }
    }
}

__device__ __forceinline__ void rwkv_unit(const Args& a, int chain, LAS unsigned char* lds) {
    const int tid = threadIdx.x, lane = tid & 63, wv = tid >> 6;
    const int b = chain >> 4, h = chain & 15;
    const bf16_t* Z = (const bf16_t*)(a.ws + WS_Z); bf16_t* YB = (bf16_t*)(a.ws + WS_YB);
    LAS float* Rr = (LAS float*)(lds + 0); LAS float* Ww = (LAS float*)(lds + 16384); LAS float* Kk = (LAS float*)(lds + 32768); LAS float* Vv = (LAS float*)(lds + 49152);
    LAS float* KKn = (LAS float*)(lds + 65536); LAS float* Bb = (LAS float*)(lds + 81920); LAS float* Yy = (LAS float*)(lds + 98304);
    LAS bf16_t* XW = (LAS bf16_t*)(lds + 114688); LAS bf16_t* XA = (LAS bf16_t*)(lds + 122880); LAS bf16_t* XG = (LAS bf16_t*)(lds + 131072); LAS float* BON = (LAS float*)(lds + 147456);
    const float* mu = a.in[I_MU];
    float s[16];
#pragma unroll
    for (int j = 0; j < 16; ++j) s[j] = 0.f;
    for (int n = 0; n < 64; ++n) {
        const int t0 = b * SEQ + n * 64;
        for (int task = tid; task < 64 * 56; task += 512) {
            const int t = task / 56, gq = task - t * 56;
            int zc, mi;
            if (gq < 8) { zc = ZR + h * 64 + gq * 8; mi = h * 64 + gq * 8; }
            else if (gq < 16) { zc = ZK2 + h * 64 + (gq - 8) * 8; mi = 1024 + h * 64 + (gq - 8) * 8; }
            else if (gq < 24) { zc = ZV2 + h * 64 + (gq - 16) * 8; mi = 2048 + h * 64 + (gq - 16) * 8; }
            else if (gq < 32) { zc = ZXW + (gq - 24) * 8; mi = 3072 + (gq - 24) * 8; }
            else if (gq < 40) { zc = ZXA + (gq - 32) * 8; mi = 3136 + (gq - 32) * 8; }
            else { zc = ZXG + (gq - 40) * 8; mi = 3200 + (gq - 40) * 8; }
            const u32x4 cu = *(const u32x4*)(Z + (size_t)(t0 + t) * ZLD + zc);
            u32x4 pv = (u32x4){0u, 0u, 0u, 0u};
            if (!(n == 0 && t == 0)) pv = *(const u32x4*)(Z + (size_t)(t0 + t - 1) * ZLD + zc);
            const f32x4 m0 = *(const f32x4*)(mu + mi), m1 = *(const f32x4*)(mu + mi + 4);
            float u[8];
            { float c;
              c = bflo(cu.x); u[0] = c + m0[0] * (bflo(pv.x) - c); c = bfhi(cu.x); u[1] = c + m0[1] * (bfhi(pv.x) - c);
              c = bflo(cu.y); u[2] = c + m0[2] * (bflo(pv.y) - c); c = bfhi(cu.y); u[3] = c + m0[3] * (bfhi(pv.y) - c);
              c = bflo(cu.z); u[4] = c + m1[0] * (bflo(pv.z) - c); c = bfhi(cu.z); u[5] = c + m1[1] * (bfhi(pv.z) - c);
              c = bflo(cu.w); u[6] = c + m1[2] * (bflo(pv.w) - c); c = bfhi(cu.w); u[7] = c + m1[3] * (bfhi(pv.w) - c); }
            if (gq < 24) { LAS float* dst = (gq < 8 ? Rr : (gq < 16 ? Kk : Vv)) + t * 64 + (gq & 7) * 8;
#pragma unroll
                for (int q = 0; q < 8; ++q) dst[q] = u[q]; }
            else if (gq < 32) { LAS bf16_t* dst = XW + t * 64 + (gq - 24) * 8;
#pragma unroll
                for (int q = 0; q < 8; ++q) dst[q] = f2bf(tanhf(u[q])); }
            else if (gq < 40) { LAS bf16_t* dst = XA + t * 64 + (gq - 32) * 8;
#pragma unroll
                for (int q = 0; q < 8; ++q) dst[q] = f2bf(u[q]); }
            else { LAS bf16_t* dst = XG + t * 128 + (gq - 40) * 8;
#pragma unroll
                for (int q = 0; q < 8; ++q) dst[q] = f2bf(sigmoidf_(u[q])); }
        }
        __syncthreads();
        {
            const int j = lane, hj = h * 64 + j;
            float aw[8], aa[8];
            const float w0v = a.in[I_W0][hj], a0v = a.in[I_A0][hj];
#pragma unroll
            for (int tt = 0; tt < 8; ++tt) { aw[tt] = w0v; aa[tt] = a0v; }
            const float* w2 = a.in[I_W2] + hj; const float* a2 = a.in[I_A2] + hj;
            for (int m = 0; m < 64; m += 2) {
                const float w2a = w2[(size_t)m * 1024], w2b = w2[(size_t)(m + 1) * 1024], a2a = a2[(size_t)m * 1024], a2b = a2[(size_t)(m + 1) * 1024];
#pragma unroll
                for (int tt = 0; tt < 8; ++tt) { const int t = wv * 8 + tt;
                    const unsigned xw = *(const LAS unsigned*)(XW + t * 64 + m), xa = *(const LAS unsigned*)(XA + t * 64 + m);
                    aw[tt] += bflo(xw) * w2a + bfhi(xw) * w2b; aa[tt] += bflo(xa) * a2a + bfhi(xa) * a2b; }
            }
            const float kkw = a.in[I_KK][hj], kaw = a.in[I_KA][hj], rkw = a.in[I_RK][hj];
#pragma unroll
            for (int tt = 0; tt < 8; ++tt) { const int t = wv * 8 + tt;
                const float y = -aw[tt];
                const float sp = fmaxf(y, 0.f) + log1pf(__expf(-fabsf(y)));
                const float wlog = -sp - 0.5f;
                const float decay = __expf(-__expf(wlog));
                const float asig = sigmoidf_(aa[tt]);
                const float kraw = Kk[t * 64 + j], rr = Rr[t * 64 + j];
                const float kkr = kraw * kkw;
                const float ss = wave_sum(kkr * kkr);
                const float kk = kkr / fmaxf(sqrtf(ss), 1e-12f);
                const float kmod = kraw * (1.0f + (asig - 1.0f) * kaw);
                const float bon = wave_sum(rr * kmod * rkw);
                Ww[t * 64 + j] = decay; Kk[t * 64 + j] = kmod; KKn[t * 64 + j] = kk; Bb[t * 64 + j] = kk * asig;
                if (lane == 0) BON[t] = bon; }
        }
        __syncthreads();
        if (wv < 4) {
            const int i = wv * 16 + (lane >> 2), j0 = (lane & 3) * 16;
            for (int t = 0; t < 64; ++t) {
                float av[16], wv_[16], bv[16], kv[16], rv[16];
#pragma unroll
                for (int q = 0; q < 4; ++q) {
                    const f32x4 x0 = *(const LAS f32x4*)(KKn + t * 64 + j0 + q * 4), x1 = *(const LAS f32x4*)(Ww + t * 64 + j0 + q * 4), x2 = *(const LAS f32x4*)(Bb + t * 64 + j0 + q * 4),
                                x3 = *(const LAS f32x4*)(Kk + t * 64 + j0 + q * 4), x4 = *(const LAS f32x4*)(Rr + t * 64 + j0 + q * 4);
#pragma unroll
                    for (int r = 0; r < 4; ++r) { av[q * 4 + r] = -x0[r]; wv_[q * 4 + r] = x1[r]; bv[q * 4 + r] = x2[r]; kv[q * 4 + r] = x3[r]; rv[q * 4 + r] = x4[r]; }
                }
                const float vi = Vv[t * 64 + i];
                float sa = 0.f;
#pragma unroll
                for (int q = 0; q < 16; ++q) sa += s[q] * av[q];
                sa += __shfl_xor(sa, 1); sa += __shfl_xor(sa, 2);
                float y = 0.f;
#pragma unroll
                for (int q = 0; q < 16; ++q) { s[q] = s[q] * wv_[q] + sa * bv[q] + vi * kv[q]; y += s[q] * rv[q]; }
                y += __shfl_xor(y, 1); y += __shfl_xor(y, 2);
                if ((lane & 3) == 0) Yy[t * 64 + i] = y;
            }
        }
        __syncthreads();
        {
            const int i = lane, hi = h * 64 + i;
            float ag[8];
#pragma unroll
            for (int tt = 0; tt < 8; ++tt) ag[tt] = 0.f;
            const float* g2 = a.in[I_G2] + hi;
            for (int m = 0; m < 128; m += 2) {
                const float ga = g2[(size_t)m * 1024], gb = g2[(size_t)(m + 1) * 1024];
#pragma unroll
                for (int tt = 0; tt < 8; ++tt) { const unsigned xg = *(const LAS unsigned*)(XG + (wv * 8 + tt) * 128 + m); ag[tt] += bflo(xg) * ga + bfhi(xg) * gb; }
            }
            const float lw = a.in[I_LNW][hi], lb = a.in[I_LNB][hi];
#pragma unroll
            for (int tt = 0; tt < 8; ++tt) { const int t = wv * 8 + tt;
                const float y = Yy[t * 64 + i];
                const float mean = wave_sum(y) * (1.0f / 64.0f);
                const float d = y - mean;
                const float var = wave_sum(d * d) * (1.0f / 64.0f);
                float yn = d * rsqrtf(var + 64e-5f) * lw + lb;
                yn += BON[t] * Vv[t * 64 + i];
                YB[(size_t)(t0 + t) * DM + hi] = f2bf(yn * ag[tt]); }
        }
        __syncthreads();
    }
}

constexpr int RL = 72;
constexpr int RLF = 68;
constexpr int RO_SB0 = 0, RO_SB1 = 9216, RO_GT = 18432, RO_BON = 27648, RO_GC = 27904, RO_WTOT = 28160, RO_MUL = 30208  , RO_LAST = 32000  ;
constexpr int RO_AM = 33280, RO_RM = RO_AM + 9216, RO_BM = RO_RM + 9216, RO_KM = RO_BM + 9216, RO_BH = RO_KM + 9216, RO_KH = RO_BH + 9216, RO_VT = RO_KH + 9216;
constexpr int RO_E = RO_VT + 9216;
constexpr int RO_XW = RO_E, RO_XA = RO_E + 9216, RO_XG = RO_E + 18432;
constexpr int RO_WPT = RO_E, RO_APT = RO_E + 17408;
constexpr int RO_RRB = RO_E + 35840, RO_KRB = RO_RRB + 9216, RO_VRB = RO_KRB + 9216;
constexpr int RO_LF = RO_E, RO_LAK = RO_E + 17408, RO_LRB = RO_LAK + 9216, RO_LRK = RO_LRB + 9216, RO_YY = RO_LRK + 9216;
constexpr int RO_ZT = RO_YY, RO_W = RO_YY + 6912, RO_X1T = RO_BM, RO_UT = RO_KM;
static_assert(RO_YY + 17408 <= RO_VRB + 9216 && RO_VRB + 9216 <= MISC_OFF, "rwkv LDS map");

__device__ __forceinline__ bf16x8 lds_frag(const LAS bf16_t* base, int row0, int ld, int kofs, int lane) {
    return *(const LAS bf16x8*)(base + (row0 + (lane & 15)) * ld + kofs + (lane >> 4) * 8);
}
#define MFMA16(a, b, c) __builtin_amdgcn_mfma_f32_16x16x32_bf16(a, b, c, 0, 0, 0)

#define LDS_BAR() do { asm volatile("s_waitcnt lgkmcnt(0)" ::: "memory"); __builtin_amdgcn_s_barrier(); asm volatile("" ::: "memory"); } while (0)
__device__ __forceinline__ int rw_zcol(int gq, int h) {
    return gq < 8 ? ZR + h * 64 + gq * 8 : gq < 16 ? ZK2 + h * 64 + (gq - 8) * 8 : gq < 24 ? ZV2 + h * 64 + (gq - 16) * 8 : gq < 32 ? ZXW + (gq - 24) * 8 : gq < 40 ? ZXA + (gq - 32) * 8 : ZXG + (gq - 40) * 8;
}
__device__ __forceinline__ int rw_mucol(int gq, int h) {
    return gq < 8 ? h * 64 + gq * 8 : gq < 16 ? 1024 + h * 64 + (gq - 8) * 8 : gq < 24 ? 2048 + h * 64 + (gq - 16) * 8 : gq < 32 ? 3072 + (gq - 24) * 8 : gq < 40 ? 3136 + (gq - 32) * 8 : 3200 + (gq - 40) * 8;
}
__device__ __forceinline__ void rwkv_fast_unit(const Args& a, int chain, LAS unsigned char* lds) {
    const int tid0 = threadIdx.x, lane0 = tid0 & 63, wv = __builtin_amdgcn_readfirstlane(tid0 >> 6);
    const int b = chain >> 4, h = chain & 15;
#define RW_LANES int lane = lane0; asm volatile("" : "+v"(lane)); const int fr = lane & 15, fq = lane >> 4, tid = wv * 64 + lane; (void)fr; (void)fq; (void)tid;
    const bf16_t* Z = (const bf16_t*)(a.ws + WS_Z); bf16_t* YB = (bf16_t*)(a.ws + WS_YB);
    const float* mu = a.in[I_MU];
    LAS bf16_t* GT = (LAS bf16_t*)(lds + RO_GT); LAS float* BON = (LAS float*)(lds + RO_BON); LAS float* GC = (LAS float*)(lds + RO_GC); LAS float* WTOT = (LAS float*)(lds + RO_WTOT);
    LAS bf16_t* AM = (LAS bf16_t*)(lds + RO_AM); LAS bf16_t* RM = (LAS bf16_t*)(lds + RO_RM); LAS bf16_t* BM = (LAS bf16_t*)(lds + RO_BM); LAS bf16_t* KM = (LAS bf16_t*)(lds + RO_KM);
    LAS bf16_t* BH = (LAS bf16_t*)(lds + RO_BH); LAS bf16_t* KH = (LAS bf16_t*)(lds + RO_KH); LAS bf16_t* VT = (LAS bf16_t*)(lds + RO_VT);
    LAS bf16_t* XW = (LAS bf16_t*)(lds + RO_XW); LAS bf16_t* XA = (LAS bf16_t*)(lds + RO_XA); LAS bf16_t* XG = (LAS bf16_t*)(lds + RO_XG);
    LAS float* WPT = (LAS float*)(lds + RO_WPT); LAS float* APT = (LAS float*)(lds + RO_APT);
    LAS bf16_t* RRB = (LAS bf16_t*)(lds + RO_RRB); LAS bf16_t* KRB = (LAS bf16_t*)(lds + RO_KRB); LAS bf16_t* VRB = (LAS bf16_t*)(lds + RO_VRB);
    LAS float* LF = (LAS float*)(lds + RO_LF); LAS bf16_t* LAK = (LAS bf16_t*)(lds + RO_LAK); LAS bf16_t* LRB = (LAS bf16_t*)(lds + RO_LRB); LAS bf16_t* LRK = (LAS bf16_t*)(lds + RO_LRK);
    LAS float* YY = (LAS float*)(lds + RO_YY); LAS bf16_t* Wm = (LAS bf16_t*)(lds + RO_W);
    LAS bf16_t* X1T = (LAS bf16_t*)(lds + RO_X1T); LAS bf16_t* UT = (LAS bf16_t*)(lds + RO_UT); LAS bf16_t* ZT = (LAS bf16_t*)(lds + RO_ZT);

    bf16x8 fw[2], fa[2], fg[4]; float w0v, a0v, kkw, kaw, rkw, lnw, lnb; f32x4 st[2]; u32x4 pre[7];
    const int nt_ = wv & 3;
    {
    RW_LANES
    const int hjf = h * 64 + nt_ * 16 + fr;
#pragma unroll
    for (int ks = 0; ks < 2; ++ks) { unsigned pw[4], pa[4];
#pragma unroll
        for (int q = 0; q < 4; ++q) { const int m = ks * 32 + fq * 8 + q * 2;
            pw[q] = pk2(a.in[I_W2][(size_t)m * 1024 + hjf], a.in[I_W2][(size_t)(m + 1) * 1024 + hjf]); pa[q] = pk2(a.in[I_A2][(size_t)m * 1024 + hjf], a.in[I_A2][(size_t)(m + 1) * 1024 + hjf]); }
        u32x4 t; t.x = pw[0]; t.y = pw[1]; t.z = pw[2]; t.w = pw[3]; fw[ks] = __builtin_bit_cast(bf16x8, t);
        t.x = pa[0]; t.y = pa[1]; t.z = pa[2]; t.w = pa[3]; fa[ks] = __builtin_bit_cast(bf16x8, t); }
#pragma unroll
    for (int ks = 0; ks < 4; ++ks) { unsigned pg[4];
#pragma unroll
        for (int q = 0; q < 4; ++q) { const int m = ks * 32 + fq * 8 + q * 2; pg[q] = pk2(a.in[I_G2][(size_t)m * 1024 + hjf], a.in[I_G2][(size_t)(m + 1) * 1024 + hjf]); }
        u32x4 t; t.x = pg[0]; t.y = pg[1]; t.z = pg[2]; t.w = pg[3]; fg[ks] = __builtin_bit_cast(bf16x8, t); }
    const int hj = h * 64 + lane;
    w0v = a.in[I_W0][hj]; a0v = a.in[I_A0][hj]; kkw = a.in[I_KK][hj]; kaw = a.in[I_KA][hj]; rkw = a.in[I_RK][hj]; lnw = a.in[I_LNW][hj]; lnb = a.in[I_LNB][hj];
    st[0] = (f32x4){0.f, 0.f, 0.f, 0.f}; st[1] = st[0];
    for (int idx = tid; idx < 64 * RL / 2; idx += 512) ((LAS unsigned*)(lds + RO_SB0))[idx] = 0u;
    if (tid < 448) { const int gq = tid >> 3; ((LAS float*)(lds + RO_MUL))[tid] = mu[rw_mucol(gq, h) + (tid & 7)]; }
    if (tid < 224) ((LAS unsigned*)(lds + RO_LAST))[tid] = 0u;
#pragma unroll
    for (int i = 0; i < 7; ++i) pre[i] = *(const u32x4*)(Z + (size_t)(b * SEQ + lane) * ZLD + rw_zcol(wv + 8 * i, h));
    }
    LDS_BAR();

    for (int n = 0; n < 64; ++n) {
        const int t0 = b * SEQ + n * 64;
        LAS bf16_t* SB = (LAS bf16_t*)(lds + ((n & 1) ? RO_SB1 : RO_SB0)); LAS bf16_t* SBn = (LAS bf16_t*)(lds + ((n & 1) ? RO_SB0 : RO_SB1)); LAS bf16_t* WTR = SBn;
        {
        RW_LANES
        LAS float* MUL = (LAS float*)(lds + RO_MUL); LAS u32x4* LAST = (LAS u32x4*)(lds + RO_LAST);
        const int t = lane;
#pragma unroll
        for (int i = 0; i < 7; ++i) {
            const int gq = wv + 8 * i;
            const u32x4 cu = pre[i];
            u32x4 pv; pv.x = __shfl_up(cu.x, 1); pv.y = __shfl_up(cu.y, 1); pv.z = __shfl_up(cu.z, 1); pv.w = __shfl_up(cu.w, 1);
            if (lane == 0) pv = LAST[gq];
            if (lane == 63) LAST[gq] = cu;
            if (n + 1 < 64) pre[i] = *(const u32x4*)(Z + (size_t)(t0 + 64 + lane) * ZLD + rw_zcol(gq, h));
            const f32x4 m0 = *(const LAS f32x4*)(MUL + gq * 8), m1 = *(const LAS f32x4*)(MUL + gq * 8 + 4);
            float u[8];
            { float c;
              c = bflo(cu.x); u[0] = c + m0[0] * (bflo(pv.x) - c); c = bfhi(cu.x); u[1] = c + m0[1] * (bfhi(pv.x) - c);
              c = bflo(cu.y); u[2] = c + m0[2] * (bflo(pv.y) - c); c = bfhi(cu.y); u[3] = c + m0[3] * (bfhi(pv.y) - c);
              c = bflo(cu.z); u[4] = c + m1[0] * (bflo(pv.z) - c); c = bfhi(cu.z); u[5] = c + m1[1] * (bfhi(pv.z) - c);
              c = bflo(cu.w); u[6] = c + m1[2] * (bflo(pv.w) - c); c = bfhi(cu.w); u[7] = c + m1[3] * (bfhi(pv.w) - c); }
            LAS bf16_t* dst;
            if (gq < 8) dst = RRB + t * RL + gq * 8;
            else if (gq < 16) dst = KRB + t * RL + (gq - 8) * 8;
            else if (gq < 24) dst = VRB + t * RL + (gq - 16) * 8;
            else if (gq < 32) { dst = XW + t * RL + (gq - 24) * 8;
#pragma unroll
                for (int q = 0; q < 8; ++q) u[q] = tanhf_(u[q]); }
            else if (gq < 40) dst = XA + t * RL + (gq - 32) * 8;
            else { dst = XG + t * 136 + (gq - 40) * 8;
#pragma unroll
                for (int q = 0; q < 8; ++q) u[q] = sigmoidf_(u[q]); }
            u32x4 w; w.x = pk2(u[0], u[1]); w.y = pk2(u[2], u[3]); w.z = pk2(u[4], u[5]); w.w = pk2(u[6], u[7]);
            *(LAS u32x4*)dst = w;
        }
        }
        LDS_BAR();
        {
        RW_LANES
        {
            f32x4 cw[2], ca[2], cg[2];
            bf16x8 xw[2][2], xa[2][2], xg[2][4];
#pragma unroll
            for (int q = 0; q < 2; ++q) { const int mt = (wv >> 2) + 2 * q;
#pragma unroll
                for (int ks = 0; ks < 2; ++ks) { xw[q][ks] = lds_frag(XW, mt * 16, RL, ks * 32, lane); xa[q][ks] = lds_frag(XA, mt * 16, RL, ks * 32, lane); }
#pragma unroll
                for (int ks = 0; ks < 4; ++ks) xg[q][ks] = lds_frag(XG, mt * 16, 136, ks * 32, lane); }
            LDS_BAR();
#pragma unroll
            for (int q = 0; q < 2; ++q) { const int mt = (wv >> 2) + 2 * q;
                cw[q] = (f32x4){0.f, 0.f, 0.f, 0.f}; ca[q] = cw[q]; cg[q] = cw[q];
#pragma unroll
                for (int ks = 0; ks < 2; ++ks) { cw[q] = MFMA16(xw[q][ks], fw[ks], cw[q]); ca[q] = MFMA16(xa[q][ks], fa[ks], ca[q]); }
#pragma unroll
                for (int ks = 0; ks < 4; ++ks) cg[q] = MFMA16(xg[q][ks], fg[ks], cg[q]);
                const int jj = nt_ * 16 + fr, tt0 = mt * 16 + fq * 4;
                *(LAS f32x4*)(WPT + jj * RLF + tt0) = cw[q]; *(LAS f32x4*)(APT + jj * RLF + tt0) = ca[q];
                u32x2 gw; gw.x = pk2(cg[q][0], cg[q][1]); gw.y = pk2(cg[q][2], cg[q][3]);
                *(LAS u32x2*)(GT + jj * RL + tt0) = gw; }
        }
        }
        LDS_BAR();
        for (int rep_ = 0; rep_ < RW_REP_EW; ++rep_) {
        RW_LANES
        {
            const int j = lane, tb = wv * 8;
            float wp[8], ap[8], lw[8], asg[8], kmod[8], kkv[8], rr[8], bon[8];
            { const f32x4 x0 = *(const LAS f32x4*)(WPT + j * RLF + tb), x1 = *(const LAS f32x4*)(WPT + j * RLF + tb + 4), y0 = *(const LAS f32x4*)(APT + j * RLF + tb), y1 = *(const LAS f32x4*)(APT + j * RLF + tb + 4);
#pragma unroll
              for (int q = 0; q < 4; ++q) { wp[q] = x0[q] + w0v; wp[q + 4] = x1[q] + w0v; ap[q] = y0[q] + a0v; ap[q + 4] = y1[q] + a0v; } }
#pragma unroll
            for (int tt = 0; tt < 8; ++tt) { const int t = tb + tt;
                const float y = -wp[tt];
                const float sp = softplusf_(y);
                lw[tt] = -__expf(-sp - 0.5f);
                                asg[tt] = sigmoidf_(ap[tt]);
                const float kraw = bf2f(KRB[t * RL + j]); rr[tt] = bf2f(RRB[t * RL + j]);
                const float kkr = kraw * kkw;
                const float ss = wave_sum(kkr * kkr);
                kkv[tt] = kkr * rsqrtf(fmaxf(ss, 1e-24f));
                kmod[tt] = kraw * (1.0f + (asg[tt] - 1.0f) * kaw);
                bon[tt] = wave_sum(rr[tt] * kmod[tt] * rkw); }
            float cum[8]; cum[0] = lw[0];
#pragma unroll
            for (int tt = 1; tt < 8; ++tt) cum[tt] = cum[tt - 1] + lw[tt];
            WTOT[wv * 64 + j] = cum[7];
#pragma unroll
            for (int tt = 0; tt < 8; ++tt) if (lane == tt) BON[tb + tt] = bon[tt];
            LDS_BAR();
            float off = 0.f, tot = 0.f;
#pragma unroll
            for (int w8 = 0; w8 < 8; ++w8) { const float x = WTOT[w8 * 64 + j]; tot += x; if (w8 < wv) off += x; }
            if (wv == 0) GC[j] = __expf(tot);
            unsigned pbh[8], pkh[8], pvt[8];
            const float gcv = __expf(tot); float eprev = __expf(off);
#pragma unroll
            for (int tt = 0; tt < 8; ++tt) { const int t = tb + tt;
                const float c = off + cum[tt];
                const float e1 = __expf(c), ep = eprev, ei = frcp(e1), eh = gcv * ei; eprev = e1;
                const float av = -kkv[tt], bv = kkv[tt] * asg[tt];
                const unsigned short sam = f2bf(av * ep), srm = f2bf(rr[tt] * e1), sbm = f2bf(bv * ei), skm = f2bf(kmod[tt] * ei);
                AM[t * RL + j] = sam; RM[t * RL + j] = srm; BM[t * RL + j] = sbm; KM[t * RL + j] = skm;
                pbh[tt] = f2bf(bv * eh); pkh[tt] = f2bf(kmod[tt] * eh); pvt[tt] = VRB[t * RL + j]; }
            u32x4 w;
            w.x = pbh[0] | (pbh[1] << 16); w.y = pbh[2] | (pbh[3] << 16); w.z = pbh[4] | (pbh[5] << 16); w.w = pbh[6] | (pbh[7] << 16); *(LAS u32x4*)(BH + j * RL + tb) = w;
            w.x = pkh[0] | (pkh[1] << 16); w.y = pkh[2] | (pkh[3] << 16); w.z = pkh[4] | (pkh[5] << 16); w.w = pkh[6] | (pkh[7] << 16); *(LAS u32x4*)(KH + j * RL + tb) = w;
            w.x = pvt[0] | (pvt[1] << 16); w.y = pvt[2] | (pvt[3] << 16); w.z = pvt[4] | (pvt[5] << 16); w.w = pvt[6] | (pvt[7] << 16); *(LAS u32x4*)(VT + j * RL + tb) = w;
        }
        LDS_BAR();
        }
        {
        RW_LANES
#pragma unroll
        for (int q = 0; q < 2; ++q) { const int tile = wv + 8 * q, sbk = tile >> 2, tbk = tile & 3;
            f32x4 pab = (f32x4){0.f, 0.f, 0.f, 0.f};
            if (sbk <= tbk) {
#pragma unroll
                for (int ks = 0; ks < 2; ++ks) pab = MFMA16(lds_frag(BM, sbk * 16, RL, ks * 32, lane), lds_frag(AM, tbk * 16, RL, ks * 32, lane), pab); }
            const int t = tbk * 16 + fr, s0 = sbk * 16 + fq * 4;
            f32x4 lf;
#pragma unroll
            for (int r = 0; r < 4; ++r) lf[r] = (s0 + r < t) ? pab[r] : 0.f;
            *(LAS f32x4*)(LF + t * RLF + s0) = lf; }
        }
        LDS_BAR();
        for (int rep_ = 0; rep_ < RW_REP_AB; ++rep_) {
        RW_LANES
        if (wv == 0) {
            const int d = fq, c = fr;
            float T[16];
#pragma unroll
            for (int i = 0; i < 16; ++i) {
                float a0 = (i == c) ? 1.0f : 0.0f, a1 = 0.f, a2 = 0.f, a3 = 0.f;
#pragma unroll
                for (int jq = 0; jq < (i + 3) / 4; ++jq) { const f32x4 l4 = *(const LAS f32x4*)(LF + (d * 16 + i) * RLF + d * 16 + jq * 4);
                    if (jq * 4 + 0 < i) a0 += l4[0] * T[jq * 4 + 0]; if (jq * 4 + 1 < i) a1 += l4[1] * T[jq * 4 + 1]; if (jq * 4 + 2 < i) a2 += l4[2] * T[jq * 4 + 2]; if (jq * 4 + 3 < i) a3 += l4[3] * T[jq * 4 + 3]; }
                T[i] = (a0 + a1) + (a2 + a3);
                }
#pragma unroll
            for (int i = 0; i < 16; ++i) Wm[(d * 16 + i) * RL + d * 16 + c] = f2bf(T[i]);
            u32x4 w0, w1;
            w0.x = pk2(T[0], T[1]); w0.y = pk2(T[2], T[3]); w0.z = pk2(T[4], T[5]); w0.w = pk2(T[6], T[7]); w1.x = pk2(T[8], T[9]); w1.y = pk2(T[10], T[11]); w1.z = pk2(T[12], T[13]); w1.w = pk2(T[14], T[15]);
            *(LAS u32x4*)(WTR + (d * 16 + c) * RL + d * 16) = w0; *(LAS u32x4*)(WTR + (d * 16 + c) * RL + d * 16 + 8) = w1;
        } else {
            if (wv == 1) {
#pragma unroll
                for (int q = 0; q < 3; ++q) { const int idx = lane + 64 * q, blk = idx >> 5, rem = idx & 31, row = rem >> 1, hf = rem & 1;
                    const int bi = blk < 3 ? 0 : (blk < 5 ? 1 : 2), bj = blk < 3 ? blk + 1 : (blk < 5 ? blk - 1 : 3);
                    *(LAS u32x4*)(Wm + (bi * 16 + row) * RL + bj * 16 + hf * 8) = (u32x4){0u, 0u, 0u, 0u}; }
            }
            for (int tile = wv - 1; tile < 16; tile += 7) { const int sbk = tile >> 2, tbk = tile & 3;
                f32x4 pak = (f32x4){0.f, 0.f, 0.f, 0.f}, prb = pak, prk = pak;
                if (sbk <= tbk) {
#pragma unroll
                    for (int ks = 0; ks < 2; ++ks) { const bf16x8 fb = lds_frag(BM, sbk * 16, RL, ks * 32, lane), fk = lds_frag(KM, sbk * 16, RL, ks * 32, lane), fam = lds_frag(AM, tbk * 16, RL, ks * 32, lane), frm = lds_frag(RM, tbk * 16, RL, ks * 32, lane);
                        pak = MFMA16(fk, fam, pak); prb = MFMA16(fb, frm, prb); prk = MFMA16(fk, frm, prk); } }
                const int t = tbk * 16 + fr, s0 = sbk * 16 + fq * 4;
                u32x2 wak, wrb, wrk; float xak[4], xrb[4], xrk[4];
#pragma unroll
                for (int r = 0; r < 4; ++r) { const int s = s0 + r; xak[r] = (s < t) ? pak[r] : 0.f; xrb[r] = (s <= t) ? prb[r] : 0.f; xrk[r] = (s <= t) ? prk[r] : 0.f; }
                wak.x = pk2(xak[0], xak[1]); wak.y = pk2(xak[2], xak[3]); wrb.x = pk2(xrb[0], xrb[1]); wrb.y = pk2(xrb[2], xrb[3]); wrk.x = pk2(xrk[0], xrk[1]); wrk.y = pk2(xrk[2], xrk[3]);
                *(LAS u32x2*)(LAK + t * RL + s0) = wak; *(LAS u32x2*)(LRB + t * RL + s0) = wrb; *(LAS u32x2*)(LRK + t * RL + s0) = wrk; }
        }
        LDS_BAR();
        }
        for (int rep_ = 0; rep_ < RW_REP_AB; ++rep_) {
        RW_LANES
        if (wv < 3) {
            const int jc = wv;
            LAS bf16_t* zt = ZT + wv * (16 * RL);
            for (int bi = jc + 1; bi < 4; ++bi) {
                f32x4 z = (f32x4){0.f, 0.f, 0.f, 0.f};
                for (int kb = jc; kb < bi; kb += 2) {
                    const int blk = kb + (fq >> 1);
                    const bool on = blk < bi;
                    bf16x8 fa_ = (bf16x8){0, 0, 0, 0, 0, 0, 0, 0}, fb_ = fa_;
                    if (on) { const f32x4 l0 = *(const LAS f32x4*)(LF + (bi * 16 + fr) * RLF + blk * 16 + (fq & 1) * 8), l1 = *(const LAS f32x4*)(LF + (bi * 16 + fr) * RLF + blk * 16 + (fq & 1) * 8 + 4);
                        u32x4 t; t.x = pk2(l0[0], l0[1]); t.y = pk2(l0[2], l0[3]); t.z = pk2(l1[0], l1[1]); t.w = pk2(l1[2], l1[3]); fa_ = __builtin_bit_cast(bf16x8, t);
                        fb_ = *(const LAS bf16x8*)(WTR + (jc * 16 + fr) * RL + blk * 16 + (fq & 1) * 8); }
                    z = MFMA16(fa_, fb_, z);
                }
                { u32x2 w; w.x = pk2(z[0], z[1]); w.y = pk2(z[2], z[3]); *(LAS u32x2*)(zt + fr * RL + fq * 4) = w; }
                asm volatile("s_waitcnt lgkmcnt(0)" ::: "memory");
                bf16x8 ta = (bf16x8){0, 0, 0, 0, 0, 0, 0, 0}, zb = ta;
                if (fq < 2) { ta = *(const LAS bf16x8*)(Wm + (bi * 16 + fr) * RL + bi * 16 + fq * 8); zb = *(const LAS bf16x8*)(zt + fr * RL + fq * 8); }
                f32x4 wn = (f32x4){0.f, 0.f, 0.f, 0.f};
                wn = MFMA16(ta, zb, wn);
#pragma unroll
                for (int r = 0; r < 4; ++r) Wm[(bi * 16 + fq * 4 + r) * RL + jc * 16 + fr] = f2bf(wn[r]);
                { u32x2 w; w.x = pk2(wn[0], wn[1]); w.y = pk2(wn[2], wn[3]); *(LAS u32x2*)(WTR + (jc * 16 + fr) * RL + bi * 16 + fq * 4) = w; }
                asm volatile("s_waitcnt lgkmcnt(0)" ::: "memory");
            }
        } else {
            for (int tile = wv - 3; tile < 16; tile += 5) { const int mt = tile >> 2, nt = tile & 3;
                f32x4 c = (f32x4){0.f, 0.f, 0.f, 0.f};
#pragma unroll
                for (int ks = 0; ks < 2; ++ks) { c = MFMA16(lds_frag(AM, mt * 16, RL, ks * 32, lane), lds_frag(SB, nt * 16, RL, ks * 32, lane), c); c = MFMA16(lds_frag(LAK, mt * 16, RL, ks * 32, lane), lds_frag(VT, nt * 16, RL, ks * 32, lane), c); }
                u32x2 w; w.x = pk2(c[0], c[1]); w.y = pk2(c[2], c[3]); *(LAS u32x2*)(X1T + (nt * 16 + fr) * RL + mt * 16 + fq * 4) = w; }
        }
        LDS_BAR();
        }
        {
        RW_LANES
#pragma unroll
        for (int q = 0; q < 2; ++q) { const int tile = wv + 8 * q, mt = tile >> 2, nt = tile & 3;
            f32x4 c = (f32x4){0.f, 0.f, 0.f, 0.f};
#pragma unroll
            for (int ks = 0; ks < 2; ++ks) c = MFMA16(lds_frag(Wm, mt * 16, RL, ks * 32, lane), lds_frag(X1T, nt * 16, RL, ks * 32, lane), c);
            u32x2 w; w.x = pk2(c[0], c[1]); w.y = pk2(c[2], c[3]); *(LAS u32x2*)(UT + (nt * 16 + fr) * RL + mt * 16 + fq * 4) = w; }
        }
        LDS_BAR();
        {
        RW_LANES
#pragma unroll
        for (int q = 0; q < 2; ++q) { const int tile = wv + 8 * q, mt = tile >> 2, nt = tile & 3;
            f32x4 c = (f32x4){0.f, 0.f, 0.f, 0.f};
#pragma unroll
            for (int ks = 0; ks < 2; ++ks) { c = MFMA16(lds_frag(RM, mt * 16, RL, ks * 32, lane), lds_frag(SB, nt * 16, RL, ks * 32, lane), c);
                c = MFMA16(lds_frag(LRB, mt * 16, RL, ks * 32, lane), lds_frag(UT, nt * 16, RL, ks * 32, lane), c); c = MFMA16(lds_frag(LRK, mt * 16, RL, ks * 32, lane), lds_frag(VT, nt * 16, RL, ks * 32, lane), c); }
            *(LAS f32x4*)(YY + (nt * 16 + fr) * RLF + mt * 16 + fq * 4) = c;
            const f32x4 g4 = *(const LAS f32x4*)(GC + mt * 16 + fq * 4);
            f32x4 s = st[q] * g4;
#pragma unroll
            for (int ks = 0; ks < 2; ++ks) { s = MFMA16(lds_frag(BH, mt * 16, RL, ks * 32, lane), lds_frag(UT, nt * 16, RL, ks * 32, lane), s); s = MFMA16(lds_frag(KH, mt * 16, RL, ks * 32, lane), lds_frag(VT, nt * 16, RL, ks * 32, lane), s); }
            st[q] = s;
            u32x2 w; w.x = pk2(s[0], s[1]); w.y = pk2(s[2], s[3]); *(LAS u32x2*)(SBn + (nt * 16 + fr) * RL + mt * 16 + fq * 4) = w; }
        }
        LDS_BAR();
        for (int rep_ = 0; rep_ < RW_REP_EW; ++rep_) {
        RW_LANES
        {
            const int i = lane, tb = wv * 8;
            const f32x4 y0 = *(const LAS f32x4*)(YY + i * RLF + tb), y1 = *(const LAS f32x4*)(YY + i * RLF + tb + 4);
            const u32x4 v8 = *(const LAS u32x4*)(VT + i * RL + tb), g8 = *(const LAS u32x4*)(GT + i * RL + tb);
            const float yv[8] = {y0[0], y0[1], y0[2], y0[3], y1[0], y1[1], y1[2], y1[3]};
            const float vv[8] = {bflo(v8.x), bfhi(v8.x), bflo(v8.y), bfhi(v8.y), bflo(v8.z), bfhi(v8.z), bflo(v8.w), bfhi(v8.w)};
            const float gv[8] = {bflo(g8.x), bfhi(g8.x), bflo(g8.y), bfhi(g8.y), bflo(g8.z), bfhi(g8.z), bflo(g8.w), bfhi(g8.w)};
#pragma unroll
            for (int tt = 0; tt < 8; ++tt) { const int t = tb + tt;
                const float mean = wave_sum(yv[tt]) * (1.0f / 64.0f);
                const float dlt = yv[tt] - mean;
                const float var = wave_sum(dlt * dlt) * (1.0f / 64.0f);
                float yn = dlt * rsqrtf(var + 64e-5f) * lnw + lnb;
                yn += BON[t] * vv[tt];
                YB[(size_t)(t0 + t) * DM + h * 64 + i] = f2bf(yn * gv[tt]); }
        }
        LDS_BAR();
        }
    }
#undef RW_LANES
}

__device__ __forceinline__ void gla_unit(const Args& a, int unit, LAS unsigned char* lds) {
    const int tid = threadIdx.x, lane = tid & 63, wv = tid >> 6;
    const int b = unit >> 2, h = unit & 3;
    const bf16_t* Z = (const bf16_t*)(a.ws + WS_Z); bf16_t* YA = (bf16_t*)(a.ws + WS_H);
    LAS float* Q = (LAS float*)(lds + 0); LAS float* Kx = (LAS float*)(lds + 16384); LAS float* Ax = (LAS float*)(lds + 32768); LAS float* V = (LAS float*)(lds + 49152);
    LAS float* O = (LAS float*)(lds + 81920); LAS float* GL = (LAS float*)(lds + 114688);
    const int dv = tid >> 1, hf = tid & 1;
    float s[64];
#pragma unroll
    for (int j = 0; j < 64; ++j) s[j] = 0.f;
    for (int nb = 0; nb < 128; ++nb) {
        const int t0 = b * SEQ + nb * 32;
        for (int task = tid; task < 32 * 66; task += 512) {
            const int t = task / 66, g = task - t * 66;
            int zc; LAS float* dst;
            if (g < 16) { zc = ZQ + h * 128 + g * 8; dst = Q + t * 128 + g * 8; }
            else if (g < 32) { zc = ZK + h * 128 + (g - 16) * 8; dst = Kx + t * 128 + (g - 16) * 8; }
            else if (g < 64) { zc = ZV + h * 256 + (g - 32) * 8; dst = V + t * 256 + (g - 32) * 8; }
            else { zc = ZGL + (g - 64) * 8; dst = GL + t * 16 + (g - 64) * 8; }
            const u32x4 cu = *(const u32x4*)(Z + (size_t)(t0 + t) * ZLD + zc);
            dst[0] = bflo(cu.x); dst[1] = bfhi(cu.x); dst[2] = bflo(cu.y); dst[3] = bfhi(cu.y); dst[4] = bflo(cu.z); dst[5] = bfhi(cu.z); dst[6] = bflo(cu.w); dst[7] = bfhi(cu.w);
        }
        LDS_BAR();
        for (int idx = tid; idx < 32 * 128; idx += 512) {
            const int t = idx >> 7, d = idx & 127;
            float acc = a.in[I_GBIAS][h * 128 + d];
#pragma unroll
            for (int m = 0; m < 16; ++m) acc += GL[t * 16 + m] * a.in[I_GUP][m * 512 + h * 128 + d];
            const float ls = fminf(acc, 0.f) - log1pf(__expf(-fabsf(acc)));
            Ax[t * 128 + d] = __expf(ls * (1.0f / 16.0f));
        }
        LDS_BAR();
        for (int t = 0; t < 32; ++t) {
            const float vv = V[t * 256 + dv];
            float o = 0.f;
#pragma unroll
            for (int q = 0; q < 16; ++q) {
                const f32x4 a4 = *(const LAS f32x4*)(Ax + t * 128 + hf * 64 + q * 4), k4 = *(const LAS f32x4*)(Kx + t * 128 + hf * 64 + q * 4), q4 = *(const LAS f32x4*)(Q + t * 128 + hf * 64 + q * 4);
#pragma unroll
                for (int r = 0; r < 4; ++r) { s[q * 4 + r] = s[q * 4 + r] * a4[r] + k4[r] * vv; o += q4[r] * s[q * 4 + r]; }
            }
            o += __shfl_xor(o, 1);
            if (hf == 0) O[t * 256 + dv] = o * 0.08838834764831845f;
        }
        LDS_BAR();
#pragma unroll
        for (int tt = 0; tt < 4; ++tt) {
            const int t = wv * 4 + tt;
            const f32x4 o4 = *(const LAS f32x4*)(O + t * 256 + lane * 4);
            const float ss = wave_sum(o4[0] * o4[0] + o4[1] * o4[1] + o4[2] * o4[2] + o4[3] * o4[3]);
            const float rs = rsqrtf(ss * (1.0f / 256.0f) + 1e-5f);
            const u32x2 og = *(const u32x2*)(Z + (size_t)(t0 + t) * ZLD + ZOG + h * 256 + lane * 4);
            const f32x4 ng = *(const f32x4*)(a.in[I_GNG] + lane * 4);
            const float g0 = bflo(og.x), g1 = bfhi(og.x), g2 = bflo(og.y), g3 = bfhi(og.y);
            u32x2 w;
            w.x = pk2(o4[0] * rs * ng[0] * (g0 * sigmoidf_(g0)), o4[1] * rs * ng[1] * (g1 * sigmoidf_(g1)));
            w.y = pk2(o4[2] * rs * ng[2] * (g2 * sigmoidf_(g2)), o4[3] * rs * ng[3] * (g3 * sigmoidf_(g3)));
            *(u32x2*)(YA + (size_t)(t0 + t) * DM + h * 256 + lane * 4) = w;
        }
        LDS_BAR();
    }
}
constexpr int GP = 136;
constexpr int GO_QS = 0, GO_KS = 17408, GO_QI = 34816, GO_KE = 52224  , GO_VT = 70656  , GO_P = 107520  , GO_GLT = GO_P  ;
constexpr int GO_LAT = 116736  , GO_O = GO_LAT  , GO_TOT = 151552  , GO_LA32 = 153600, GO_GD = 154112, GO_SS = 154624  , GO_NG = 156672  ;
static_assert(GO_NG + 1024 <= MISC_OFF, "gla LDS map");
__device__ __forceinline__ void gla_fast_unit(const Args& a, int unit, LAS unsigned char* lds) {
    const int tid0 = threadIdx.x, lane0 = tid0 & 63, wv = __builtin_amdgcn_readfirstlane(tid0 >> 6);
    const int b = unit >> 2, h = unit & 3;
#define GL_LANES int lane = lane0; asm volatile("" : "+v"(lane)); const int fr = lane & 15, fq = lane >> 4, tid = wv * 64 + lane; (void)fr; (void)fq; (void)tid;
    const bf16_t* Z = (const bf16_t*)(a.ws + WS_Z); bf16_t* YA = (bf16_t*)(a.ws + WS_H);
    LAS bf16_t* QS = (LAS bf16_t*)(lds + GO_QS); LAS bf16_t* KS = (LAS bf16_t*)(lds + GO_KS); LAS bf16_t* QI = (LAS bf16_t*)(lds + GO_QI); LAS bf16_t* KE = (LAS bf16_t*)(lds + GO_KE);
    LAS bf16_t* VT = (LAS bf16_t*)(lds + GO_VT); LAS bf16_t* P = (LAS bf16_t*)(lds + GO_P); LAS bf16_t* GLT = (LAS bf16_t*)(lds + GO_GLT); LAS float* LAT = (LAS float*)(lds + GO_LAT);
    LAS bf16_t* O = (LAS bf16_t*)(lds + GO_O); LAS float* TOT = (LAS float*)(lds + GO_TOT); LAS float* LA32 = (LAS float*)(lds + GO_LA32); LAS float* GD = (LAS float*)(lds + GO_GD); LAS float* SS = (LAS float*)(lds + GO_SS);
    bf16x8 fgu[4]; float gbias[4];
    u32x4 pv_[4], pqk_[4], pog_[4], pgl_;
    f32x4 S[8][2];
    {
    GL_LANES
#pragma unroll
    for (int q = 0; q < 4; ++q) { const int d = ((wv >> 2) + 2 * q) * 16 + fr; unsigned pw[4];
#pragma unroll
        for (int r = 0; r < 4; ++r) { const int m = fq * 8 + r * 2; pw[r] = (fq < 2) ? pk2(a.in[I_GUP][m * 512 + h * 128 + d], a.in[I_GUP][(m + 1) * 512 + h * 128 + d]) : 0u; }
        u32x4 t; t.x = pw[0]; t.y = pw[1]; t.z = pw[2]; t.w = pw[3]; fgu[q] = __builtin_bit_cast(bf16x8, t);
        gbias[q] = a.in[I_GBIAS][h * 128 + d]; }
#pragma unroll
    for (int dt = 0; dt < 8; ++dt) { S[dt][0] = (f32x4){0.f, 0.f, 0.f, 0.f}; S[dt][1] = S[dt][0]; }
    { const int tb0 = b * SEQ;
#pragma unroll
      for (int it = 0; it < 4; ++it) { const int task = tid + it * 512, g = wv + 8 * it;
          pv_[it] = *(const u32x4*)(Z + (size_t)(tb0 + lane) * ZLD + ZV + h * 256 + g * 8);
          const int arr = task >> 10, tq = (task >> 4) & 63, gq = task & 15;
          pqk_[it] = *(const u32x4*)(Z + (size_t)(tb0 + tq) * ZLD + (arr ? ZK : ZQ) + h * 128 + gq * 8); }
      pgl_ = (u32x4){0u, 0u, 0u, 0u};
      if (tid < 256) ((LAS float*)(lds + GO_NG))[tid] = a.in[I_GNG][tid];
      if (tid < 128) pgl_ = *(const u32x4*)(Z + (size_t)(tb0 + (tid >> 1)) * ZLD + ZGL + (tid & 1) * 8);
#pragma unroll
      for (int q = 0; q < 4; ++q) pog_[q] = *(const u32x4*)(Z + (size_t)(tb0 + (tid >> 3)) * ZLD + ZOG + h * 256 + (tid & 7) * 32 + q * 8); }
    }
    for (int n = 0; n < 64; ++n) {
        const int t0 = b * SEQ + n * 64;
        {
        GL_LANES
#pragma unroll
        for (int it = 0; it < 4; ++it) { const int g = wv + 8 * it;
            const u32x4 cu = pv_[it];
            LAS bf16_t* dst = VT + (g * 8) * RL + lane;
            dst[0] = (bf16_t)(cu.x & 0xffffu); dst[RL] = (bf16_t)(cu.x >> 16); dst[2 * RL] = (bf16_t)(cu.y & 0xffffu); dst[3 * RL] = (bf16_t)(cu.y >> 16);
            dst[4 * RL] = (bf16_t)(cu.z & 0xffffu); dst[5 * RL] = (bf16_t)(cu.z >> 16); dst[6 * RL] = (bf16_t)(cu.w & 0xffffu); dst[7 * RL] = (bf16_t)(cu.w >> 16);
            const int task = tid + it * 512, arr = task >> 10, tq = (task >> 4) & 63, gq = task & 15;
            *(LAS u32x4*)((arr ? KS : QS) + tq * GP + gq * 8) = pqk_[it]; }
        if (tid < 128) { const int t = tid >> 1, g = tid & 1; *(LAS u32x4*)(GLT + t * 40 + g * 8) = pgl_; }
        else if (tid < 256) { const int q = tid - 128, t = q >> 1, g = q & 1; *(LAS u32x4*)(GLT + t * 40 + 16 + g * 8) = (u32x4){0u, 0u, 0u, 0u}; }
        if (n + 1 < 64) {
#pragma unroll
            for (int it = 0; it < 4; ++it) { const int g = wv + 8 * it;
                pv_[it] = *(const u32x4*)(Z + (size_t)(t0 + 64 + lane) * ZLD + ZV + h * 256 + g * 8);
                const int task = tid + it * 512, arr = task >> 10, tq = (task >> 4) & 63, gq = task & 15;
                pqk_[it] = *(const u32x4*)(Z + (size_t)(t0 + 64 + tq) * ZLD + (arr ? ZK : ZQ) + h * 128 + gq * 8); }
            if (tid < 128) pgl_ = *(const u32x4*)(Z + (size_t)(t0 + 64 + (tid >> 1)) * ZLD + ZGL + (tid & 1) * 8);
        }
        }
        LDS_BAR();
        {
        GL_LANES
        const int mt = wv & 3;
        const bf16x8 fa_ = *(const LAS bf16x8*)(GLT + (mt * 16 + fr) * 40 + fq * 8);
#pragma unroll
        for (int q = 0; q < 4; ++q) { const int nt = (wv >> 2) + 2 * q;
            f32x4 c = (f32x4){0.f, 0.f, 0.f, 0.f};
            c = MFMA16(fa_, fgu[q], c);
            f32x4 la;
#pragma unroll
            for (int r = 0; r < 4; ++r) { const float x = c[r] + gbias[q]; la[r] = -softplusf_(-x) * (1.0f / 16.0f); }
            *(LAS f32x4*)(LAT + (nt * 16 + fr) * RLF + mt * 16 + fq * 4) = la; }
        }
        LDS_BAR();
        {
        GL_LANES
        const int d = tid & 127, tg = tid >> 7, tb = tg * 16;
        float p[16];
#pragma unroll
        for (int q = 0; q < 4; ++q) { const f32x4 x = *(const LAS f32x4*)(LAT + d * RLF + tb + q * 4); p[q * 4] = x[0]; p[q * 4 + 1] = x[1]; p[q * 4 + 2] = x[2]; p[q * 4 + 3] = x[3]; }
#pragma unroll
        for (int i = 1; i < 16; ++i) p[i] += p[i - 1];
        TOT[tg * 128 + d] = p[15];
        if (tg == 2) LA32[d] = p[0];
        LDS_BAR();
        const float T0 = TOT[d], T1 = TOT[128 + d], T2 = TOT[256 + d], T3 = TOT[384 + d];
        const float off = (tg > 0 ? T0 : 0.f) + (tg > 1 ? T1 : 0.f) + (tg > 2 ? T2 : 0.f);
        const float bref = T0 + T1 + LA32[d], bend = (T0 + T1) + (T2 + T3);
        if (tg == 0) GD[d] = __expf(bend);
        const float eref = __expf(bref), eend = __expf(bend - bref);
        unsigned ke[16];
#pragma unroll
        for (int i = 0; i < 16; ++i) { const int t = tb + i;
            const float bb = off + p[i];
            const float qv = bf2f(QS[t * GP + d]) * 0.08838834764831845f, kv = bf2f(KS[t * GP + d]);
            const float eq = __expf(bb - bref), ek = frcp(eq); QS[t * GP + d] = f2bf(qv * eq); KS[t * GP + d] = f2bf(kv * ek); QI[t * GP + d] = f2bf(qv * (eq * eref));
            ke[i] = f2bf(kv * (ek * eend)); }
        u32x4 w;
        w.x = ke[0] | (ke[1] << 16); w.y = ke[2] | (ke[3] << 16); w.z = ke[4] | (ke[5] << 16); w.w = ke[6] | (ke[7] << 16); *(LAS u32x4*)(KE + d * RL + tb) = w;
        w.x = ke[8] | (ke[9] << 16); w.y = ke[10] | (ke[11] << 16); w.z = ke[12] | (ke[13] << 16); w.w = ke[14] | (ke[15] << 16); *(LAS u32x4*)(KE + d * RL + tb + 8) = w;
        }
        LDS_BAR();
        {
        GL_LANES
#pragma unroll
        for (int q = 0; q < 2; ++q) { const int tile = wv + 8 * q, sbk = tile >> 2, tbk = tile & 3;
            f32x4 c = (f32x4){0.f, 0.f, 0.f, 0.f};
            if (sbk <= tbk) {
#pragma unroll
                for (int ks = 0; ks < 4; ++ks) c = MFMA16(lds_frag(KS, sbk * 16, GP, ks * 32, lane), lds_frag(QS, tbk * 16, GP, ks * 32, lane), c); }
            const int t = tbk * 16 + fr, s0 = sbk * 16 + fq * 4;
            float x[4];
#pragma unroll
            for (int r = 0; r < 4; ++r) x[r] = (s0 + r <= t) ? c[r] : 0.f;
            u32x2 w; w.x = pk2(x[0], x[1]); w.y = pk2(x[2], x[3]); *(LAS u32x2*)(P + t * RL + s0) = w; }
        }
        LDS_BAR();
        {
        GL_LANES
        bf16x8 sb[4][2];
#pragma unroll
        for (int ks = 0; ks < 4; ++ks)
#pragma unroll
            for (int v2 = 0; v2 < 2; ++v2) { const f32x4 lo = S[2 * ks][v2], hi = S[2 * ks + 1][v2];
                u32x4 t; t.x = pk2(lo[0], lo[1]); t.y = pk2(lo[2], lo[3]); t.z = pk2(hi[0], hi[1]); t.w = pk2(hi[2], hi[3]); sb[ks][v2] = __builtin_bit_cast(bf16x8, t); }
        const int v0 = wv * 32;
#pragma unroll
        for (int mt = 0; mt < 4; ++mt) {
            f32x4 o0 = (f32x4){0.f, 0.f, 0.f, 0.f}, o1 = o0;
#pragma unroll
            for (int ks = 0; ks < 2; ++ks) { const bf16x8 fp = lds_frag(P, mt * 16, RL, ks * 32, lane);
                o0 = MFMA16(fp, lds_frag(VT, v0, RL, ks * 32, lane), o0); o1 = MFMA16(fp, lds_frag(VT, v0 + 16, RL, ks * 32, lane), o1); }
#pragma unroll
            for (int ks = 0; ks < 4; ++ks) {
                const u32x2 qa = *(const LAS u32x2*)(QI + (mt * 16 + fr) * GP + ks * 32 + fq * 4), qb = *(const LAS u32x2*)(QI + (mt * 16 + fr) * GP + ks * 32 + 16 + fq * 4);
                u32x4 t; t.x = qa.x; t.y = qa.y; t.z = qb.x; t.w = qb.y; const bf16x8 fqi = __builtin_bit_cast(bf16x8, t);
                o0 = MFMA16(fqi, sb[ks][0], o0); o1 = MFMA16(fqi, sb[ks][1], o1); }
#pragma unroll
            for (int r = 0; r < 4; ++r) { const int t = mt * 16 + fq * 4 + r;
                O[t * 264 + v0 + fr] = f2bf(o0[r]); O[t * 264 + v0 + 16 + fr] = f2bf(o1[r]);
                float x = o0[r] * o0[r] + o1[r] * o1[r];
                x = rowsum16(x);
                if (fr == 0) SS[wv * 64 + t] = x; }
        }
        bf16x8 fv[2][2];
#pragma unroll
        for (int ks = 0; ks < 2; ++ks) { fv[ks][0] = lds_frag(VT, v0, RL, ks * 32, lane); fv[ks][1] = lds_frag(VT, v0 + 16, RL, ks * 32, lane); }
#pragma unroll
        for (int dt = 0; dt < 8; ++dt) { const f32x4 g4 = *(const LAS f32x4*)(GD + dt * 16 + fq * 4);
            f32x4 s0 = S[dt][0] * g4, s1 = S[dt][1] * g4;
#pragma unroll
            for (int ks = 0; ks < 2; ++ks) { const bf16x8 fk = lds_frag(KE, dt * 16, RL, ks * 32, lane);
                s0 = MFMA16(fk, fv[ks][0], s0); s1 = MFMA16(fk, fv[ks][1], s1); }
            S[dt][0] = s0; S[dt][1] = s1; }
        }
        LDS_BAR();
        {
        GL_LANES
        const int t = tid >> 3, c0 = (tid & 7) * 32;
        float ss = 0.f;
#pragma unroll
        for (int w8 = 0; w8 < 8; ++w8) ss += SS[w8 * 64 + t];
        const float rs = rsqrtf(ss * (1.0f / 256.0f) + 1e-5f);
        const bf16_t* ogp = Z + (size_t)(t0 + t) * ZLD + ZOG + h * 256 + c0; bf16_t* yp = YA + (size_t)(t0 + t) * DM + h * 256 + c0;
#pragma unroll
        for (int q = 0; q < 4; ++q) { const u32x4 o8 = *(const LAS u32x4*)(O + t * 264 + c0 + q * 8); const u32x4 g8 = pog_[q];
            const f32x4 n0 = *(const LAS f32x4*)((LAS float*)(lds + GO_NG) + c0 + q * 8), n1 = *(const LAS f32x4*)((LAS float*)(lds + GO_NG) + c0 + q * 8 + 4);
            const float ov[8] = {bflo(o8.x), bfhi(o8.x), bflo(o8.y), bfhi(o8.y), bflo(o8.z), bfhi(o8.z), bflo(o8.w), bfhi(o8.w)};
            const float gv[8] = {bflo(g8.x), bfhi(g8.x), bflo(g8.y), bfhi(g8.y), bflo(g8.z), bfhi(g8.z), bflo(g8.w), bfhi(g8.w)};
            const float nv[8] = {n0[0], n0[1], n0[2], n0[3], n1[0], n1[1], n1[2], n1[3]};
            float y[8];
#pragma unroll
            for (int e = 0; e < 8; ++e) y[e] = ov[e] * rs * nv[e] * (gv[e] * sigmoidf_(gv[e]));
            u32x4 w; w.x = pk2(y[0], y[1]); w.y = pk2(y[2], y[3]); w.z = pk2(y[4], y[5]); w.w = pk2(y[6], y[7]);
            *(u32x4*)(yp + q * 8) = w; }
        if (n + 1 < 64) {
#pragma unroll
            for (int q = 0; q < 4; ++q) pog_[q] = *(const u32x4*)(ogp + (size_t)64 * ZLD + q * 8); }
        }
        LDS_BAR();
    }
#undef GL_LANES
}

#ifndef SCAN_PROBE
#define SCAN_PROBE 0
#endif
template <int hb> __device__ __forceinline__ void scan_phase(const Args& a, LAS unsigned char* lds) {
    if (blockIdx.x >= 160) {
        if constexpr (hb == 0) {
            prologue_phase(a, lds, (int)blockIdx.x - 160, (int)gridDim.x - 160, PRO_T3, PRO_T5);
            rmsnorm_phase(a.in[I_X] + (size_t)TH * DM, a.in[I_NMG], (bf16_t*)(a.out + (size_t)TH * DM), (int)blockIdx.x - 160, (int)gridDim.x - 160);
        }
        return;
    }
    for (int u = blockIdx.x; u < 160; u += gridDim.x) {
        if (u < 128) {
            rwkv_fast_unit(a, u, lds);
            if constexpr (SCAN_PROBE == 1) rwkv_fast_unit(a, u, lds);
        } else {
            gla_fast_unit(a, u - 128, lds);
            if constexpr (SCAN_PROBE == 2) gla_fast_unit(a, u - 128, lds);
        }
    }
}

__device__ __forceinline__ void router_phase(const Args& a, int hb, LAS unsigned char* lds) {
    const int tid = threadIdx.x, lane = tid & 63, wv = tid >> 6;
    LAS float* wt = (LAS float*)lds;
    LAS unsigned* hist = (LAS unsigned*)(lds + 131072);
    const float* rw = a.in[I_RW];
    for (int idx = tid; idx < 32 * 1024; idx += 512) { const int k = idx >> 5, e = idx & 31; wt[e * 1024 + k] = rw[idx]; }
    if (tid < 32) hist[tid] = 0u;
    __syncthreads();
    const float* x1 = a.out + (size_t)hb * TH * DM; bf16_t* H2 = (bf16_t*)(a.ws + WS_H2);
    int* tope = (int*)(a.ws + WS_TOPE); float* topg = (float*)(a.ws + WS_TOPG);
    const float* gain = a.in[I_NFG];
    const int gw = blockIdx.x * 8 + wv, nw = gridDim.x * 8;
    for (int row = gw; row < TH; row += nw) {
        const f32x4* xr = (const f32x4*)(x1 + (size_t)row * DM);
        f32x4 v[4]; float ss = 0.f;
#pragma unroll
        for (int i = 0; i < 4; ++i) { v[i] = xr[i * 64 + lane]; ss += v[i][0] * v[i][0] + v[i][1] * v[i][1] + v[i][2] * v[i][2] + v[i][3] * v[i][3]; }
        ss = wave_sum(ss);
        const float rs = rsqrtf(ss * (1.0f / 1024.0f) + 1e-6f);
#pragma unroll
        for (int i = 0; i < 4; ++i) { const f32x4 g = ((const f32x4*)gain)[i * 64 + lane]; v[i] = v[i] * rs * g;
            if constexpr (MOE_FP8) { *(unsigned*)((unsigned char*)H2 + (size_t)row * DM + (i * 64 + lane) * 4) = pk4_fp8(v[i][0], v[i][1], v[i][2], v[i][3]); }
            else { u32x2 w; w.x = pk2(v[i][0], v[i][1]); w.y = pk2(v[i][2], v[i][3]);
            *(u32x2*)(H2 + (size_t)row * DM + (i * 64 + lane) * 4) = w; } }
        float p[32];
#pragma unroll
        for (int e = 0; e < 32; ++e) { float acc = 0.f;
#pragma unroll
            for (int i = 0; i < 4; ++i) { const f32x4 w4 = *(const LAS f32x4*)(wt + e * 1024 + (i * 64 + lane) * 4); acc += v[i][0] * w4[0] + v[i][1] * w4[1] + v[i][2] * w4[2] + v[i][3] * w4[3]; }
            p[e] = acc; }
#pragma unroll
        for (int i = 0; i < 16; ++i) { const bool up = (lane & 32) != 0; const float send = up ? p[i] : p[i + 16], keep = up ? p[i + 16] : p[i]; p[i] = keep + __shfl_xor(send, 32); }
#pragma unroll
        for (int i = 0; i < 8; ++i) { const bool up = (lane & 16) != 0; const float send = up ? p[i] : p[i + 8], keep = up ? p[i + 8] : p[i]; p[i] = keep + __shfl_xor(send, 16); }
#pragma unroll
        for (int i = 0; i < 4; ++i) { const bool up = (lane & 8) != 0; const float send = up ? p[i] : p[i + 4], keep = up ? p[i + 4] : p[i]; p[i] = keep + __shfl_xor(send, 8); }
#pragma unroll
        for (int i = 0; i < 2; ++i) { const bool up = (lane & 4) != 0; const float send = up ? p[i] : p[i + 2], keep = up ? p[i + 2] : p[i]; p[i] = keep + __shfl_xor(send, 4); }
        { const bool up = (lane & 2) != 0; const float send = up ? p[0] : p[1], keep = up ? p[1] : p[0]; p[0] = keep + __shfl_xor(send, 2); }
        p[0] += __shfl_xor(p[0], 1);
        const int e = lane >> 1;
        float val = p[0] + a.in[I_RB][e];
        float tv[4]; int te[4];
#pragma unroll
        for (int k = 0; k < 4; ++k) {
            const float m = wave_max(val);
            const int cand = (val == m) ? e : 64;
            const int em = wave_min_i(cand);
            tv[k] = m; te[k] = em;
            if (e == em) val = -3.0e38f;
        }
        const float e1 = __expf(tv[1] - tv[0]), e2 = __expf(tv[2] - tv[0]), e3 = __expf(tv[3] - tv[0]);
        const float inv = 1.0f / (1.0f + e1 + e2 + e3);
        if (lane == 0) {
            *(int4*)(tope + (size_t)row * 4) = make_int4(te[0], te[1], te[2], te[3]);
            *(float4*)(topg + (size_t)row * 4) = make_float4(inv, e1 * inv, e2 * inv, e3 * inv);
#pragma unroll
            for (int k = 0; k < 4; ++k) __hip_atomic_fetch_add(hist + te[k], 1u, __ATOMIC_RELAXED, __HIP_MEMORY_SCOPE_WORKGROUP);
        }
    }
    __syncthreads();
    if (tid < 32) { unsigned* cnt = (unsigned*)(a.ws + WS_CTL) + CW_CNT + hb * 64; __hip_atomic_fetch_add(cnt + tid, hist[tid], __ATOMIC_RELAXED, __HIP_MEMORY_SCOPE_AGENT); }
    __syncthreads();
}

__device__ __forceinline__ void assign_phase(const Args& a, int hb, LAS unsigned char* lds) {
    const int tid = threadIdx.x;
    LAS unsigned* sm = (LAS unsigned*)lds;
    unsigned* ctl = (unsigned*)(a.ws + WS_CTL);
    if (tid < 64) {
        const int e = tid & 31;
        const unsigned c = __hip_atomic_load(ctl + CW_CNT + hb * 64 + e, __ATOMIC_RELAXED, __HIP_MEMORY_SCOPE_AGENT);
        const unsigned pc = (c + 255u) & ~255u;
        unsigned incl = pc;
#pragma unroll
        for (int o = 1; o < 32; o <<= 1) { const unsigned up = __shfl_up(incl, o, 32); if (e >= o) incl += up; }
        if (tid < 32) { sm[32 + e] = incl - pc; sm[96 + e] = c; sm[128 + e] = pc; }
        if (tid == 31 && blockIdx.x == 0) ctl[CW_NBLK + hb] = incl >> 8;
    }
    __syncthreads();
    const int* tope = (const int*)(a.ws + WS_TOPE); const float* topg = (const float*)(a.ws + WS_TOPG);
    int* rtok = (int*)(a.ws + WS_RTOK); float* rgate = (float*)(a.ws + WS_RGATE); int* dest = (int*)(a.ws + WS_DEST); int* blke = (int*)(a.ws + WS_BLKE);
    for (int base_t = blockIdx.x * 128; base_t < TH; base_t += gridDim.x * 128) {
        if (tid < 32) sm[tid] = 0u;
        __syncthreads();
        const int t = base_t + (tid >> 2), k = tid & 3;
        const int e = tope[(size_t)t * 4 + k];
        const unsigned lr = __hip_atomic_fetch_add(sm + e, 1u, __ATOMIC_RELAXED, __HIP_MEMORY_SCOPE_WORKGROUP);
        __syncthreads();
        if (tid < 32) sm[64 + tid] = __hip_atomic_fetch_add(ctl + CW_CUR + hb * 64 + tid, sm[tid], __ATOMIC_RELAXED, __HIP_MEMORY_SCOPE_AGENT);
        __syncthreads();
        const int d = (int)(sm[32 + e] + sm[64 + e] + lr);
        rtok[d] = t; rgate[d] = topg[(size_t)t * 4 + k]; dest[(size_t)t * 4 + k] = d;
        __syncthreads();
    }
    for (int e = blockIdx.x; e < 32; e += gridDim.x) {
        const int ps = (int)sm[32 + e], c = (int)sm[96 + e], pc = (int)sm[128 + e];
        for (int r = ps + c + tid; r < ps + pc; r += 512) { rtok[r] = 0; rgate[r] = 0.f; }
        for (int blk = (ps >> 8) + tid; blk < ((ps + pc) >> 8); blk += 512) blke[blk] = e;
    }
}

__device__ __forceinline__ void combine_phase(const Args& a, int hb) {
    const int lane = threadIdx.x & 63, gw = blockIdx.x * 8 + (threadIdx.x >> 6), nw = gridDim.x * 8;
    float* x1 = a.out + (size_t)hb * TH * DM; const bf16_t* OUTS = (const bf16_t*)(a.ws + WS_OUTS); const int* dest = (const int*)(a.ws + WS_DEST);
    const float* gain = a.in[I_NFIN];
    for (int row = gw; row < TH; row += nw) {
        f32x4* xr = (f32x4*)(x1 + (size_t)row * DM);
        const int4 d4 = *(const int4*)(dest + (size_t)row * 4);
        const int dd[4] = {d4.x, d4.y, d4.z, d4.w};
        f32x4 v[4];
#pragma unroll
        for (int i = 0; i < 4; ++i) v[i] = xr[i * 64 + lane];
#pragma unroll
        for (int k = 0; k < 4; ++k) { const bf16_t* orow = OUTS + (size_t)dd[k] * DM;
#pragma unroll
            for (int i = 0; i < 4; ++i) { const u32x2 w = *(const u32x2*)(orow + (i * 64 + lane) * 4); v[i][0] += bflo(w.x); v[i][1] += bfhi(w.x); v[i][2] += bflo(w.y); v[i][3] += bfhi(w.y); } }
        float ss = 0.f;
#pragma unroll
        for (int i = 0; i < 4; ++i) ss += v[i][0] * v[i][0] + v[i][1] * v[i][1] + v[i][2] * v[i][2] + v[i][3] * v[i][3];
        ss = wave_sum(ss);
        const float rs = rsqrtf(ss * (1.0f / 1024.0f) + 1e-6f);
#pragma unroll
        for (int i = 0; i < 4; ++i) { const f32x4 g = ((const f32x4*)gain)[i * 64 + lane]; xr[i * 64 + lane] = v[i] * rs * g; }
    }
}

#define PH(k) (lo <= (k) && (k) < hi)
#define SEAM(k) do { if (PH(k) && PH((k) + 1)) xcd_barrier(bar); } while (0)
template <int hb> __device__ __forceinline__ void half_program(const Args& a, LAS unsigned char* lds, const XcdBarrier& bar, const int lo, const int hi) {
    unsigned char* ws = a.ws;
        const int pb = 1 + hb * 10;
        const float* xh = a.in[I_X] + (size_t)hb * TH * DM;
        float* outh = a.out + (size_t)hb * TH * DM;
        if (PH(pb + 1)) { RUNPH(2, {
            pg8::Gemm g{hb == 0 ? (const bf16_t*)(ws + WS_H) : (const bf16_t*)(a.out + (size_t)TH * DM), (const bf16_t*)(ws + WS_WIN), 1024}; pg8::StaticOrder S; S.init(TH, ZLD, gridDim.x, blockIdx.x);
            pg8::EpiZ E{(bf16_t*)(ws + WS_Z), ZLD};
            pg8::gemm_phase(lds, g, S, E);
        }); } SEAM(pb + 1);
        if (PH(pb + 2)) { RUNPH(3, { scan_phase<hb>(a, lds); }); } SEAM(pb + 2);
        if (PH(pb + 3)) { RUNPH(4, {
            pg8::StaticOrder S; S.init(TH, 1024, gridDim.x, blockIdx.x);
            { pg8::Gemm g{(const bf16_t*)(ws + WS_H), (const bf16_t*)(ws + WS_WA), 1024}; pg8::EpiGate<true> E{(const bf16_t*)(ws + WS_Z), ZGA, (bf16_t*)(ws + WS_MG)}; pg8::gemm_phase(lds, g, S, E); }
            { pg8::Gemm g{(const bf16_t*)(ws + WS_YB), (const bf16_t*)(ws + WS_WB), 1024}; pg8::EpiGate<false> E{(const bf16_t*)(ws + WS_Z), ZGB, (bf16_t*)(ws + WS_MG)}; pg8::gemm_phase(lds, g, S, E); }
        }); } SEAM(pb + 3);
        if (PH(pb + 4)) { RUNPH(5, {
            pg8::Gemm g{(const bf16_t*)(ws + WS_MG), (const bf16_t*)(ws + WS_WO), 1024}; pg8::StaticOrder S; S.init(TH, 1024, gridDim.x, blockIdx.x);
            pg8::EpiRes E{xh, outh};
            pg8::gemm_phase(lds, g, S, E);
        }); } SEAM(pb + 4);
        if (PH(pb + 5)) { RUNPH(6, { router_phase(a, hb, lds); }); } SEAM(pb + 5);
        if (PH(pb + 6)) { RUNPH(7, { assign_phase(a, hb, lds); }); } SEAM(pb + 6);
        if (PH(pb + 7)) { RUNPH(8, {
            const int nblk = (int)((const unsigned*)(ws + WS_CTL))[CW_NBLK + hb];
            pg8::Gemm g{(const bf16_t*)(ws + WS_H2), (const bf16_t*)(ws + WS_W1), MOE_FP8 ? 512 : 1024};
            pg8::MoeOrder<true> S{nblk * 8, (int)gridDim.x, (int)blockIdx.x, 3, 8, (const int*)(ws + WS_BLKE), (const int*)(ws + WS_RTOK)};
            if constexpr (MOE_FP8) { pg8::EpiSwiglu8 E{a.in[I_EB1], (unsigned char*)(ws + WS_ACT)}; pg8::gemm_phase(lds, g, S, E); }
            else { pg8::EpiSwiglu E{a.in[I_EB1], (bf16_t*)(ws + WS_ACT)}; pg8::gemm_phase(lds, g, S, E); }
        }); } SEAM(pb + 7);
        if (PH(pb + 8)) { RUNPH(9, {
            const int nblk = (int)((const unsigned*)(ws + WS_CTL))[CW_NBLK + hb];
            pg8::Gemm g{(const bf16_t*)(ws + WS_ACT), (const bf16_t*)(ws + WS_W2), MOE_FP8 ? 512 : 1024};
            pg8::MoeOrder<false, MOE_FP8 != 0> S{nblk * 4, (int)gridDim.x, (int)blockIdx.x, 2, 4, (const int*)(ws + WS_BLKE), nullptr};
            if constexpr (MOE_FP8) { pg8::EpiMoe2_8 E{a.in[I_EB2], (const float*)(ws + WS_RGATE), (bf16_t*)(ws + WS_OUTS)}; pg8::gemm_phase(lds, g, S, E); }
            else { pg8::EpiMoe2 E{a.in[I_EB2], (const float*)(ws + WS_RGATE), (bf16_t*)(ws + WS_OUTS)}; pg8::gemm_phase(lds, g, S, E); }
        }); } SEAM(pb + 8);
        if (PH(pb + 9)) { RUNPH(10, { combine_phase(a, hb); }); } SEAM(pb + 9);
}
#undef PH
#undef SEAM
constexpr int NPHASE = 21;
__global__ void __launch_bounds__(512, 2) mega(Args a) {
    extern __shared__ __attribute__((aligned(16))) unsigned char lds_raw[];
    LAS unsigned char* lds = (LAS unsigned char*)lds_raw;
    unsigned char* ws = a.ws;
    const int lo = a.ph_lo, hi = a.ph_hi;
    XcdBarrier bar; bar.bar = (unsigned*)(ws + WS_CTL); bar.x = 0; bar.st = nullptr;
    if (hi - lo > 1) {
        volatile LAS unsigned* misc = (volatile LAS unsigned*)(lds + MISC_OFF);
        if (threadIdx.x < 4) misc[threadIdx.x] = 0u;
        __syncthreads();
        bar = xcd_barrier_post((unsigned*)(ws + WS_CTL), misc);
    }
#define PH(k) (lo <= (k) && (k) < hi)
#define SEAM(k) do { if (PH(k) && PH((k) + 1)) xcd_barrier(bar); } while (0)
    if (PH(0)) { RUNPH(0, { prologue_phase(a, lds, (int)blockIdx.x, (int)gridDim.x, 0, PRO_T3); rmsnorm_phase(a.in[I_X], a.in[I_NMG], (bf16_t*)(ws + WS_H), (int)blockIdx.x, (int)gridDim.x); }); } SEAM(0);
    half_program<0>(a, lds, bar, lo, hi);
    half_program<1>(a, lds, bar, lo, hi);
#undef PH
#undef SEAM
}

extern "C" void kernel_launch(void* const* d_in, const int* in_sizes, int n_in, void* d_out, int out_size, void* d_ws, size_t ws_size, hipStream_t stream) {
    static int grid = 0;
    if (grid == 0) {
        if (n_in != 28 || out_size != 65536 * 1024 || ws_size < WS_END) { fprintf(stderr, "kernel_launch: unexpected shapes (n_in %d out %d ws %zu need %zu)\n", n_in, out_size, ws_size, (size_t)WS_END); grid = -1; return; }
        int dev = 0, cus = 0;
        if (hipGetDevice(&dev) != hipSuccess || hipDeviceGetAttribute(&cus, hipDeviceAttributeMultiprocessorCount, dev) != hipSuccess) { grid = -1; return; }
        if (hipFuncSetAttribute((const void*)mega, hipFuncAttributeMaxDynamicSharedMemorySize, LDS_BYTES) != hipSuccess) { fprintf(stderr, "kernel_launch: hipFuncSetAttribute failed\n"); grid = -1; return; }
        int per_cu = 0;
        if (hipOccupancyMaxActiveBlocksPerMultiprocessor(&per_cu, (const void*)mega, 512, LDS_BYTES) != hipSuccess || per_cu < 1) fprintf(stderr, "kernel_launch: occupancy query says %d\n", per_cu);
        (void)hipGetLastError();
        grid = cus > 256 ? 256 : cus;
    }
    if (grid < 0) return;
    (void)hipMemsetAsync((char*)d_ws + WS_CTL, 0, CTL_BYTES, stream);
    Args a{};
    for (int i = 0; i < 28; ++i) a.in[i] = (const float*)d_in[i];
    a.out = (float*)d_out; a.ws = (unsigned char*)d_ws;
#if N_LAUNCH_MODE == 0
    a.ph_lo = 0; a.ph_hi = NPHASE;
    hipLaunchKernelGGL(mega, dim3(grid), dim3(512), LDS_BYTES, stream, a);
#else
    for (int p = 0; p < NPHASE; ++p) { a.ph_lo = p; a.ph_hi = p + 1; hipLaunchKernelGGL(mega, dim3(grid), dim3(512), LDS_BYTES, stream, a); }
#endif
}
```
